# Optimizing an MI355X kernel written in HIP

```python
import math
import jax, jax.numpy as jnp
from jax import lax
import numpy as np

D_MODEL = 1024
BATCH = 4
SEQ = 8192
DEPTH = 1

N_META = 16
CHUNK = 64
PAD = CHUNK - N_META
M_HEADS = 4
R_HEADS = 4
HEAD_DIM = D_MODEL // (M_HEADS + R_HEADS)
M_WIDTH = M_HEADS * HEAD_DIM
R_WIDTH = R_HEADS * HEAD_DIM
MIX_WIDTH = M_WIDTH + R_WIDTH
PROJ_WIDTH = 4 * M_WIDTH + 4 * R_WIDTH + 2 * M_HEADS
PEER_HEADS = 8
PEER_KEYS = 128
PEER_EXPERTS = PEER_KEYS * PEER_KEYS
PEER_TOPK = 16
PEER_QDIM = 256
PEER_TOKEN_BLOCK = 256
ROPE_BASE = 10000.0
EPS = 1e-6

kernel_name = "hymba_mlstm_retnet_peer_block"

F32 = jnp.float32


def rmsnorm(x, w):
    xf = x.astype(F32)
    y = xf * lax.rsqrt(jnp.mean(xf * xf, axis=-1, keepdims=True) + EPS) * w.astype(F32)
    return y.astype(x.dtype)


def head_norm(x, w):
    H, d = x.shape[1], x.shape[3]
    mu = jnp.mean(x, axis=-1, keepdims=True)
    xc = x - mu
    var = jnp.mean(xc * xc, axis=-1, keepdims=True)
    return xc * lax.rsqrt(var + EPS) * w.astype(F32).reshape(1, H, 1, d)


def split_heads(t, n_heads):
    B, L, _ = t.shape
    return t.reshape(B, L, n_heads, -1).transpose(0, 2, 1, 3)


def merge_heads(t):
    B, H, L, d = t.shape
    return t.transpose(0, 2, 1, 3).reshape(B, L, H * d)


def to_chunks(t):
    B, H, L, d = t.shape
    return t.reshape(B, H, L // CHUNK, CHUNK, d)


def rotary(x, pos):
    half = x.shape[-1] // 2
    inv_freq = ROPE_BASE ** (-jnp.arange(half, dtype=F32) / half)
    ang = pos[:, None] * inv_freq[None, :]
    cos, sin = jnp.cos(ang), jnp.sin(ang)
    x1, x2 = x[..., :half], x[..., half:]
    return jnp.concatenate([x1 * cos - x2 * sin, x1 * sin + x2 * cos], axis=-1)


def mlstm_heads(q, k, v, i_pre, f_pre):
    B, H, N, C, dk = k.shape
    dv = v.shape[-1]
    k = k * (dk ** -0.5)
    log_f = jax.nn.log_sigmoid(f_pre)
    log_i = i_pre
    b = jnp.cumsum(log_f, axis=-1)
    g = b[..., -1]
    a = g[..., None] - b + log_i

    def step(carry, inp):
        c_st, n_st, m_st = carry
        k_c, v_c, a_c, g_c = inp
        m_new = jnp.maximum(g_c + m_st, jnp.max(a_c, axis=-1))
        decay = jnp.exp(g_c + m_st - m_new)
        w = jnp.exp(a_c - m_new[..., None])
        kw = k_c * w[..., None]
        c_new = decay[..., None, None] * c_st + jnp.einsum('bhjk,bhjv->bhkv', kw, v_c)
        n_new = decay[..., None] * n_st + jnp.sum(kw, axis=2)
        return (c_new, n_new, m_new), (c_st, n_st, m_st)

    init = (jnp.zeros((B, H, dk, dv), F32), jnp.zeros((B, H, dk), F32), jnp.zeros((B, H), F32))
    xs = (jnp.moveaxis(k, 2, 0), jnp.moveaxis(v, 2, 0), jnp.moveaxis(a, 2, 0), jnp.moveaxis(g, 2, 0))
    _, (c_prev, n_prev, m_prev) = lax.scan(step, init, xs)
    c_prev = jnp.moveaxis(c_prev, 0, 2)
    n_prev = jnp.moveaxis(n_prev, 0, 2)
    m_prev = jnp.moveaxis(m_prev, 0, 2)

    causal = jnp.tril(jnp.ones((C, C), dtype=bool))
    d_log = b[..., :, None] - b[..., None, :] + log_i[..., None, :]
    d_log = jnp.where(causal, d_log, -jnp.inf)
    inter_log = b + m_prev[..., None]
    m_t = jnp.maximum(inter_log, jnp.max(d_log, axis=-1))
    w_inter = jnp.exp(inter_log - m_t)
    s = jnp.einsum('bhncd,bhnjd->bhncj', q, k) * jnp.exp(d_log - m_t[..., None])
    num = (w_inter[..., None] * jnp.einsum('bhncd,bhndv->bhncv', q, c_prev)
           + jnp.einsum('bhncj,bhnjv->bhncv', s, v))
    den = w_inter * jnp.einsum('bhncd,bhnd->bhnc', q, n_prev) + jnp.sum(s, axis=-1)
    return num / jnp.maximum(jnp.abs(den), jnp.exp(-m_t))[..., None]


def retention_heads(q, k, v):
    B, H, N, C, dk = k.shape
    dv = v.shape[-1]
    k = k * (dk ** -0.5)
    log_gamma = jnp.log1p(-jnp.exp2(-5.0 - jnp.arange(H, dtype=F32)))
    idx = jnp.arange(C, dtype=F32)
    rel = idx[:, None] - idx[None, :]
    causal = rel >= 0
    decay_intra = jnp.where(causal, jnp.exp(log_gamma[:, None, None] * jnp.where(causal, rel, 0.0)), 0.0)
    decay_cross = jnp.exp(log_gamma[:, None] * (idx + 1.0))
    decay_state = jnp.exp(log_gamma[:, None] * (C - 1.0 - idx))
    decay_chunk = jnp.exp(log_gamma * C)
    kz = k * decay_state[None, :, None, :, None]

    def step(r_st, inp):
        k_c, v_c = inp
        r_new = decay_chunk[None, :, None, None] * r_st + jnp.einsum('bhjk,bhjv->bhkv', k_c, v_c)
        return r_new, r_st

    _, r_prev = lax.scan(step, jnp.zeros((B, H, dk, dv), F32), (jnp.moveaxis(kz, 2, 0), jnp.moveaxis(v, 2, 0)))
    r_prev = jnp.moveaxis(r_prev, 0, 2)
    s = jnp.einsum('bhncd,bhnjd->bhncj', q, k) * decay_intra[None, :, None]
    inner = jnp.einsum('bhncj,bhnjv->bhncv', s, v)
    cross = decay_cross[None, :, None, :, None] * jnp.einsum('bhncd,bhndv->bhncv', q, r_prev)
    return inner + cross


def mixer_sublayer(h, norm_w, w_in, gate_bias, m_norm_w, r_norm_w, w_out):
    B, L, _ = h.shape
    a = rmsnorm(h, norm_w)
    a = jnp.pad(a, ((0, 0), (PAD, 0), (0, 0)))
    Lp = L + PAD
    n_chunks = Lp // CHUNK
    proj = (a @ w_in).astype(F32)
    sizes = [M_WIDTH] * 4 + [R_WIDTH] * 4
    offsets = [int(o) for o in np.cumsum(sizes)]
    mq, mk, mv, mo, rq, rk, rv, rg, gates = jnp.split(proj, offsets, axis=-1)
    gates = gates + gate_bias.astype(F32)
    gates = gates.transpose(0, 2, 1).reshape(B, 2 * M_HEADS, n_chunks, CHUNK)
    i_pre, f_pre = gates[:, :M_HEADS], gates[:, M_HEADS:]

    h_m = mlstm_heads(to_chunks(split_heads(mq, M_HEADS)), to_chunks(split_heads(mk, M_HEADS)),
                      to_chunks(split_heads(mv, M_HEADS)), i_pre, f_pre)
    h_m = h_m.reshape(B, M_HEADS, Lp, HEAD_DIM)
    out_m = merge_heads(head_norm(jax.nn.sigmoid(split_heads(mo, M_HEADS)) * h_m, m_norm_w))

    pos = jnp.arange(Lp, dtype=F32) - PAD
    rq_h = rotary(split_heads(rq, R_HEADS), pos)
    rk_h = rotary(split_heads(rk, R_HEADS), pos)
    ret = retention_heads(to_chunks(rq_h), to_chunks(rk_h), to_chunks(split_heads(rv, R_HEADS)))
    ret = ret.reshape(B, R_HEADS, Lp, HEAD_DIM)
    out_r = merge_heads(jax.nn.silu(split_heads(rg, R_HEADS)) * head_norm(ret, r_norm_w))

    y = jnp.concatenate([out_m, out_r], axis=-1)[:, PAD:].astype(h.dtype)
    return y @ w_out


def peer_ffn(x, w_query, sub_keys, w_down, w_up):
    B, L, D = x.shape
    T = B * L
    TB = PEER_TOKEN_BLOCK
    n_blk = -(-T // TB)
    t = jnp.pad(x.reshape(T, D), ((0, n_blk * TB - T), (0, 0))).reshape(n_blk, TB, D)

    def block(xb):
        q = (xb @ w_query).astype(F32).reshape(TB, PEER_HEADS, 2, PEER_QDIM // 2)
        s = jnp.einsum('thpd,pnd->thpn', q, sub_keys.astype(F32))
        s1, i1 = lax.top_k(s[:, :, 0], PEER_TOPK)
        s2, i2 = lax.top_k(s[:, :, 1], PEER_TOPK)
        cand = (s1[..., :, None] + s2[..., None, :]).reshape(TB, PEER_HEADS, PEER_TOPK * PEER_TOPK)
        cidx = (i1[..., :, None] * PEER_KEYS + i2[..., None, :]).reshape(TB, PEER_HEADS, PEER_TOPK * PEER_TOPK)
        top, sel = lax.top_k(cand, PEER_TOPK)
        eidx = jnp.take_along_axis(cidx, sel, axis=-1)
        gate = jax.nn.softmax(top, axis=-1)
        u = jnp.take(w_down, eidx, axis=0)
        act = jax.nn.gelu(jnp.einsum('thkd,td->thk', u, xb).astype(F32), approximate=False)
        vv = jnp.take(w_up, eidx, axis=0)
        return jnp.einsum('thk,thkd->td', (gate * act).astype(xb.dtype), vv)

    out = lax.map(block, t).reshape(n_blk * TB, D)[:T]
    return out.reshape(B, L, D)


def setup_inputs(seed: int = 0) -> dict:
    key = jax.random.key(seed)
    ks = jax.random.split(key, 16)
    nrm = jax.random.normal
    x = nrm(ks[0], (BATCH, SEQ, D_MODEL), F32)
    meta_tokens = nrm(ks[1], (N_META, D_MODEL), F32)
    norm1_w = 1.0 + 0.01 * nrm(ks[2], (DEPTH, D_MODEL), F32)
    w_in = nrm(ks[3], (DEPTH, D_MODEL, PROJ_WIDTH), F32) * D_MODEL ** -0.5
    i_bias = 0.1 * nrm(ks[4], (DEPTH, M_HEADS), F32)
    f_bias = jnp.linspace(3.0, 6.0, M_HEADS, dtype=F32)[None, :] + 0.01 * nrm(ks[5], (DEPTH, M_HEADS), F32)
    gate_bias = jnp.concatenate([i_bias, f_bias], axis=-1)
    m_norm_w = 1.0 + 0.01 * nrm(ks[6], (DEPTH, M_WIDTH), F32)
    r_norm_w = 1.0 + 0.01 * nrm(ks[7], (DEPTH, R_WIDTH), F32)
    w_out = nrm(ks[8], (DEPTH, MIX_WIDTH, D_MODEL), F32) * MIX_WIDTH ** -0.5
    norm2_w = 1.0 + 0.01 * nrm(ks[9], (DEPTH, D_MODEL), F32)
    peer_w_query = nrm(ks[10], (DEPTH, D_MODEL, PEER_HEADS * PEER_QDIM), F32) * D_MODEL ** -0.5
    peer_sub_keys = nrm(ks[11], (DEPTH, 2, PEER_KEYS, PEER_QDIM // 2), F32) * (PEER_QDIM // 2) ** -0.5
    peer_w_down = nrm(ks[12], (DEPTH, PEER_EXPERTS, D_MODEL), F32) * D_MODEL ** -0.5
    peer_w_up = nrm(ks[13], (DEPTH, PEER_EXPERTS, D_MODEL), F32) * PEER_HEADS ** -0.5
    final_norm_w = 1.0 + 0.01 * nrm(ks[14], (D_MODEL,), F32)
    return {"x": x, "meta_tokens": meta_tokens, "norm1_w": norm1_w, "w_in": w_in,
            "gate_bias": gate_bias, "m_norm_w": m_norm_w, "r_norm_w": r_norm_w, "w_out": w_out,
            "norm2_w": norm2_w, "peer_w_query": peer_w_query, "peer_sub_keys": peer_sub_keys,
            "peer_w_down": peer_w_down, "peer_w_up": peer_w_up, "final_norm_w": final_norm_w}


def reference(x, meta_tokens, norm1_w, w_in, gate_bias, m_norm_w, r_norm_w, w_out, norm2_w,
              peer_w_query, peer_sub_keys, peer_w_down, peer_w_up, final_norm_w):
    B = x.shape[0]
    meta = jnp.broadcast_to(meta_tokens.astype(x.dtype)[None], (B, N_META, D_MODEL))
    h = jnp.concatenate([meta, x], axis=1)
    for l in range(DEPTH):
        h = h + mixer_sublayer(h, norm1_w[l], w_in[l], gate_bias[l], m_norm_w[l], r_norm_w[l], w_out[l])
        h = h + peer_ffn(rmsnorm(h, norm2_w[l]), peer_w_query[l], peer_sub_keys[l], peer_w_down[l], peer_w_up[l])
    return rmsnorm(h, final_norm_w)[:, N_META:]
```

```cpp
#include <hip/hip_runtime.h>
#include <cstdio>
#include <cstdint>
#include <type_traits>
namespace pg8 {
#define PG8_LAS __attribute__((address_space(3)))
typedef unsigned short bf16_t;
typedef short bf16x8 __attribute__((ext_vector_type(8)));
typedef float f32x4 __attribute__((ext_vector_type(4)));
typedef unsigned u32x4 __attribute__((ext_vector_type(4)));
constexpr int BM = 256, BK = 64, HALF = 128, HTB = HALF * BK * 2  , STAGE_BYTES = 8 * HTB, NXCD = 8, WGM = 8;

__host__ __device__ __forceinline__ int lds_byte(int r, int c) { const int st = (r >> 4) * 2 + (c >> 5), rr = r & 15, cc = c & 31, ob = rr * 64 + cc * 2; return st * 1024 + (ob ^ (((ob >> 9) & 1) << 5)); }
__host__ __device__ __forceinline__ void stage_rc(int b, int& R, int& C) { const int st = b / 1024, sb = b % 1024, swz = sb ^ (((sb >> 9) & 1) << 5); R = (st >> 1) * 16 + swz / 64; C = (st & 1) * 32 + (swz % 64) / 2; }
__host__ __device__ __forceinline__ int perm32(int rho) { const int n = rho >> 4, i = rho & 15; return 8 * (i >> 2) + 4 * n + (i & 3); }

struct Unit { int pm, pn; };
struct Gemm { const bf16_t* A; const bf16_t* Bt; int M, N, K; };

struct StaticOrder {
    int nM, nN, nwg, G, c;
    __host__ __device__ void init(int M, int N, int G_, int c_) { nM = M / BM; nN = N / BM; nwg = nM * nN; G = G_; c = c_; }
    __host__ __device__ bool next(int i, Unit& u) const {
        const long L = (long)i * G + c; if (L >= nwg) return false;
        int wgid = (int)L; { const int q = nwg / NXCD, r = nwg % NXCD, xcd = wgid % NXCD, off = wgid / NXCD; wgid = (xcd < r ? xcd * (q + 1) : r * (q + 1) + (xcd - r) * q) + off; }
        const int nig = WGM * nN, gid = wgid / nig, fm = gid * WGM, gsz = (nM - fm) < WGM ? (nM - fm) : WGM;
        u.pm = fm + ((wgid % nig) % gsz); u.pn = (wgid % nig) / gsz; return true;
    }
    __device__ __forceinline__ void a_ready(const Unit&) const {}
    __device__ __forceinline__ void done(const Unit&) const {}
};
__device__ __forceinline__ unsigned cvt_pk_bf16(float lo, float hi) { unsigned r; asm volatile("v_cvt_pk_bf16_f32 %0, %1, %2" : "=v"(r) : "v"(lo), "v"(hi)); return r; }
typedef unsigned u32x2 __attribute__((ext_vector_type(2)));

struct EpiProj {
    static constexpr bool PERM = true, AFTER_DRAIN = false;
    bf16_t* O; const float* rot;
    __device__ __forceinline__ void operator()(const f32x4 (&acc)[2][2][4][2], const Unit& u, int wr, int wc, int fr, int fq) const {
        const int row0 = u.pm * BM + wr * 64 + fr, col0 = u.pn * BM + wc * 32 + 8 * fq;
        const bool rotary = (u.pn >= 8 && u.pn < 12);
        const int i4 = 4 * (4 * wc + fq);
#pragma unroll
        for (int ai = 0; ai < 2; ++ai)
#pragma unroll
            for (int m = 0; m < 4; ++m) {
                const int row = row0 + ai * HALF + m * 16;
                bf16_t* rowp = O + (size_t)row * 4096 + col0;
                f32x4 cv = (f32x4){1.f, 1.f, 1.f, 1.f}, sv = (f32x4){0.f, 0.f, 0.f, 0.f};
                if (rotary) { const int pos = (row & 8191) + 16; cv = *(const f32x4*)(rot + (size_t)pos * 128 + i4); sv = *(const f32x4*)(rot + (size_t)pos * 128 + 64 + i4); }
#pragma unroll
                for (int bj = 0; bj < 2; ++bj) {
                    const f32x4 x1 = acc[ai][bj][m][0], x2 = acc[ai][bj][m][1];
                    const f32x4 v0 = x1 * cv - x2 * sv, v1 = x1 * sv + x2 * cv;
                    u32x4 w; w.x = cvt_pk_bf16(v0[0], v0[1]); w.y = cvt_pk_bf16(v0[2], v0[3]); w.z = cvt_pk_bf16(v1[0], v1[1]); w.w = cvt_pk_bf16(v1[2], v1[3]);
                    *(u32x4*)(rowp + bj * HALF) = w; }
            }
    }
};
struct EpiOut {
    static constexpr bool PERM = false, AFTER_DRAIN = false;
    const float* X; bf16_t* H1B; float* SSQ;
    __device__ __forceinline__ void operator()(const f32x4 (&acc)[2][2][4][2], const Unit& u, int wr, int wc, int fr, int fq) const {
        const int row0 = u.pm * BM + wr * 64 + fr, col0 = u.pn * BM + wc * 32 + 4 * fq;
#pragma unroll
        for (int ai = 0; ai < 2; ++ai)
#pragma unroll
            for (int m = 0; m < 4; ++m) {
                const int row = row0 + ai * HALF + m * 16; const size_t off = (size_t)row * 1024 + col0;
                float ss = 0.f;
#pragma unroll
                for (int bj = 0; bj < 2; ++bj)
#pragma unroll
                    for (int n = 0; n < 2; ++n) {
                        const f32x4 xv = *(const f32x4*)(X + off + bj * HALF + n * 16);
                        const f32x4 h = xv + acc[ai][bj][m][n];
                        u32x2 w; w.x = cvt_pk_bf16(h[0], h[1]); w.y = cvt_pk_bf16(h[2], h[3]);
                        *(u32x2*)(H1B + off + bj * HALF + n * 16) = w;
                        ss += (h[0] * h[0] + h[1] * h[1]) + (h[2] * h[2] + h[3] * h[3]); }
                SSQ[(size_t)row * 64 + u.pn * 16 + wc * 4 + fq] = ss;
                asm volatile("" ::: "memory"); }
    }
};
struct EpiF32 {
    static constexpr bool PERM = false, AFTER_DRAIN = false;
    float* C; int ldc;
    __device__ __forceinline__ void operator()(const f32x4 (&acc)[2][2][4][2], const Unit& u, int wr, int wc, int fr, int fq) const {
        const int row0 = u.pm * BM + wr * 64 + fr, col0 = u.pn * BM + wc * 32 + 4 * fq;
#pragma unroll
        for (int ai = 0; ai < 2; ++ai)
#pragma unroll
            for (int m = 0; m < 4; ++m) { float* rowp = C + (size_t)(row0 + ai * HALF + m * 16) * ldc + col0;
#pragma unroll
                for (int bj = 0; bj < 2; ++bj)
#pragma unroll
                    for (int n = 0; n < 2; ++n) *(f32x4*)(rowp + bj * HALF + n * 16) = acc[ai][bj][m][n]; }
    }
};

struct EpiF16 {
    static constexpr bool PERM = true, AFTER_DRAIN = false;
    unsigned short* C; int ldc;
    __device__ __forceinline__ void operator()(const f32x4 (&acc)[2][2][4][2], const Unit& u, int wr, int wc, int fr, int fq) const {
        typedef _Float16 h2_t __attribute__((ext_vector_type(2)));
        const int row0 = u.pm * BM + wr * 64 + fr, col0 = u.pn * BM + wc * 32 + 8 * fq;
#pragma unroll
        for (int ai = 0; ai < 2; ++ai)
#pragma unroll
            for (int m = 0; m < 4; ++m) { unsigned short* rowp = C + (size_t)(row0 + ai * HALF + m * 16) * ldc + col0;
#pragma unroll
                for (int bj = 0; bj < 2; ++bj) { const f32x4 v0 = acc[ai][bj][m][0], v1 = acc[ai][bj][m][1];
                    u32x4 w; w.x = __builtin_bit_cast(unsigned, __builtin_amdgcn_cvt_pkrtz(v0[0], v0[1])); w.y = __builtin_bit_cast(unsigned, __builtin_amdgcn_cvt_pkrtz(v0[2], v0[3]));
                    w.z = __builtin_bit_cast(unsigned, __builtin_amdgcn_cvt_pkrtz(v1[0], v1[1])); w.w = __builtin_bit_cast(unsigned, __builtin_amdgcn_cvt_pkrtz(v1[2], v1[3]));
                    *(u32x4*)(rowp + bj * HALF) = w; } }
    }
};
template <class Epi, class Sched, bool ALIGN_EPI = false, bool SP2 = false>
__device__ __forceinline__ void gemm_phase(PG8_LAS unsigned char* lds, const Gemm g, const Sched& S, const Epi& E) {
    int tid_ = threadIdx.x; asm volatile("" : "+v"(tid_));
    const int tid = tid_, wid = __builtin_amdgcn_readfirstlane(tid >> 6), lane = tid & 63, wr = wid >> 2, wc = wid & 3, fr = lane & 15, fq = lane >> 4;
    const int K = g.K, nt = K / BK;
    unsigned voffA[2], voffB[2];
#pragma unroll
    for (int i = 0; i < 2; ++i) { int R, C; stage_rc(tid * 16 + i * 8192, R, C); const int Rb = Epi::PERM ? ((R & ~31) + perm32(R & 31)) : R;
        voffA[i] = (unsigned)(R * K + C) * 2u; voffB[i] = (unsigned)(Rb * K + C) * 2u; }
    const size_t kstep = (size_t)(BK * 2);
    const size_t hstep = (size_t)HALF * K * 2;
    const size_t tstep = 2 * hstep;
    const unsigned ldsw = (unsigned)wid * 1024u;
    const int aoff = lds_byte(wr * 64 + fr, fq * 8), boff = lds_byte(wc * 32 + fr, fq * 8);
#define PG8_SA(b, h) (((b) * 2 + (h)) * HTB)
#define PG8_SB(b, h) ((4 + (b) * 2 + (h)) * HTB)
#define PG8_STAGE(bufoff, gbase, voff) do { _Pragma("unroll") for (int _i = 0; _i < 2; ++_i) \
        __builtin_amdgcn_global_load_lds((const unsigned*)((const char*)(gbase) + (voff)[_i]), (PG8_LAS unsigned*)(lds + (bufoff) + ldsw + _i * 8192), 16, 0, 0); } while (0)
#define PG8_LDA(dst, b, h) do { _Pragma("unroll") for (int m = 0; m < 4; ++m) _Pragma("unroll") for (int k = 0; k < 2; ++k) dst[m][k] = *(const PG8_LAS bf16x8*)(lds + PG8_SA(b, h) + aoff + m * 2048 + k * 1024); } while (0)
#define PG8_LDB(dst, b, h) do { _Pragma("unroll") for (int n = 0; n < 2; ++n) _Pragma("unroll") for (int k = 0; k < 2; ++k) dst[n][k] = *(const PG8_LAS bf16x8*)(lds + PG8_SB(b, h) + boff + n * 2048 + k * 1024); } while (0)
#define PG8_MMA(ai, bj, At, Bt) do { __builtin_amdgcn_s_setprio(1); _Pragma("unroll") for (int m = 0; m < 4; ++m) _Pragma("unroll") for (int n = 0; n < 2; ++n) _Pragma("unroll") for (int k = 0; k < 2; ++k) \
        acc[ai][bj][m][n] = __builtin_amdgcn_mfma_f32_16x16x32_bf16(Bt[n][k], At[m][k], acc[ai][bj][m][n], 0, 0, 0); __builtin_amdgcn_s_setprio(0); } while (0)
#define PG8_WAIT_V(n) asm volatile("s_waitcnt vmcnt(" #n ")" ::: "memory")
#define PG8_WAIT_L(n) asm volatile("s_waitcnt lgkmcnt(" #n ")" ::: "memory")
#define PG8_BAR __builtin_amdgcn_s_barrier()
#define PG8_SCHED __builtin_amdgcn_sched_barrier(0)
    Unit cur, nxt; int ui = 0;
    if (!S.next(0, cur)) return;
    f32x4 acc[2][2][4][2];
#pragma unroll
    for (int a = 0; a < 2; ++a)
#pragma unroll
        for (int b = 0; b < 2; ++b)
#pragma unroll
            for (int m = 0; m < 4; ++m)
#pragma unroll
                for (int n = 0; n < 2; ++n) acc[a][b][m][n] = (f32x4){0.f, 0.f, 0.f, 0.f};
    bf16x8 At[4][2], B0[2][2], B1[2][2];
    const char* cA = (const char*)g.A + (size_t)cur.pm * tstep; const char* cB = (const char*)g.Bt + (size_t)cur.pn * tstep;
    S.a_ready(cur);
    if constexpr (SP2) {
        PG8_STAGE(PG8_SB(0, 0), cB, voffB); PG8_STAGE(PG8_SB(0, 1), cB + hstep, voffB); PG8_STAGE(PG8_SA(0, 0), cA, voffA); PG8_STAGE(PG8_SA(0, 1), cA + hstep, voffA);
        if (wr == 1) PG8_BAR;
        PG8_WAIT_V(2); PG8_BAR;
        PG8_STAGE(PG8_SB(1, 0), cB + kstep, voffB); PG8_STAGE(PG8_SA(1, 0), cA + kstep, voffA); PG8_STAGE(PG8_SB(1, 1), cB + hstep + kstep, voffB);
        PG8_WAIT_V(6); PG8_BAR;
    } else {
        PG8_STAGE(PG8_SB(0, 0), cB, voffB); PG8_STAGE(PG8_SA(0, 0), cA, voffA); PG8_STAGE(PG8_SB(0, 1), cB + hstep, voffB); PG8_STAGE(PG8_SA(0, 1), cA + hstep, voffA);
        if (wr == 1) PG8_BAR;
        PG8_WAIT_V(4); PG8_BAR;
        PG8_STAGE(PG8_SB(1, 0), cB + kstep, voffB); PG8_STAGE(PG8_SA(1, 0), cA + kstep, voffA); PG8_STAGE(PG8_SB(1, 1), cB + hstep + kstep, voffB);
        PG8_WAIT_V(6); PG8_BAR;
    }
    for (;;) {
        const bool has_next = S.next(ui + 1, nxt);
        const char* nA = has_next ? (const char*)g.A + (size_t)nxt.pm * tstep : cA; const char* nB = has_next ? (const char*)g.Bt + (size_t)nxt.pn * tstep : cB;
        for (int t = 0; t < nt; t += 2) {
            const bool last = (t == nt - 2);
            const char* a1 = cA + (size_t)(t + 1) * kstep;
            const char* a2 = last ? nA : cA + (size_t)(t + 2) * kstep; const char* b2 = last ? nB : cB + (size_t)(t + 2) * kstep;
            const char* a3 = a2 + kstep; const char* b3 = b2 + kstep;
            if (last && has_next) S.a_ready(nxt);
            if constexpr (SP2) {
            PG8_LDB(B0, 0, 0); PG8_LDB(B1, 0, 1); PG8_SCHED; PG8_LDA(At, 0, 0); PG8_STAGE(PG8_SA(1, 1), a1 + hstep, voffA);
            PG8_WAIT_V(8); PG8_WAIT_L(0); PG8_BAR; PG8_MMA(0, 0, At, B0); PG8_MMA(0, 1, At, B1); PG8_BAR; PG8_SCHED;
            PG8_LDA(At, 0, 1); PG8_STAGE(PG8_SB(0, 0), b2, voffB); PG8_STAGE(PG8_SB(0, 1), b2 + hstep, voffB); PG8_STAGE(PG8_SA(0, 0), a2, voffA);
            PG8_WAIT_V(8); PG8_WAIT_L(0); PG8_BAR; PG8_MMA(1, 0, At, B0); PG8_MMA(1, 1, At, B1); PG8_BAR; PG8_SCHED;
            PG8_LDB(B0, 1, 0); PG8_LDB(B1, 1, 1); PG8_SCHED; PG8_LDA(At, 1, 0); PG8_STAGE(PG8_SA(0, 1), a2 + hstep, voffA);
            PG8_WAIT_V(8); PG8_WAIT_L(0); PG8_BAR; PG8_MMA(0, 0, At, B0); PG8_MMA(0, 1, At, B1); PG8_BAR; PG8_SCHED;
            PG8_LDA(At, 1, 1); PG8_STAGE(PG8_SB(1, 0), b3, voffB); PG8_STAGE(PG8_SB(1, 1), b3 + hstep, voffB); PG8_STAGE(PG8_SA(1, 0), a3, voffA);
            PG8_WAIT_V(8); PG8_WAIT_L(0); PG8_BAR; PG8_MMA(1, 0, At, B0); PG8_MMA(1, 1, At, B1); PG8_BAR; PG8_SCHED;
            } else {
            PG8_LDB(B0, 0, 0); PG8_SCHED; PG8_LDA(At, 0, 0); PG8_STAGE(PG8_SA(1, 1), a1 + hstep, voffA);
            PG8_WAIT_L(8); PG8_BAR; PG8_WAIT_L(0); PG8_MMA(0, 0, At, B0); PG8_BAR; PG8_SCHED;
            PG8_LDB(B1, 0, 1); PG8_STAGE(PG8_SB(0, 0), b2, voffB);
            PG8_BAR; PG8_WAIT_L(0); PG8_MMA(0, 1, At, B1); PG8_BAR;
            PG8_LDA(At, 0, 1); PG8_STAGE(PG8_SA(0, 0), a2, voffA);
            PG8_BAR; PG8_WAIT_L(0); PG8_MMA(1, 0, At, B0); PG8_BAR; PG8_SCHED;
            PG8_STAGE(PG8_SB(0, 1), b2 + hstep, voffB);
            PG8_WAIT_V(6); PG8_BAR; PG8_MMA(1, 1, At, B1); PG8_BAR;
            PG8_LDB(B0, 1, 0); PG8_SCHED; PG8_LDA(At, 1, 0); PG8_STAGE(PG8_SA(0, 1), a2 + hstep, voffA);
            PG8_WAIT_L(8); PG8_BAR; PG8_WAIT_L(0); PG8_MMA(0, 0, At, B0); PG8_BAR; PG8_SCHED;
            PG8_LDB(B1, 1, 1); PG8_STAGE(PG8_SB(1, 0), b3, voffB);
            PG8_BAR; PG8_WAIT_L(0); PG8_MMA(0, 1, At, B1); PG8_BAR;
            PG8_LDA(At, 1, 1); PG8_STAGE(PG8_SA(1, 0), a3, voffA);
            PG8_BAR; PG8_WAIT_L(0); PG8_MMA(1, 0, At, B0); PG8_BAR; PG8_SCHED;
            PG8_STAGE(PG8_SB(1, 1), b3 + hstep, voffB);
            PG8_WAIT_V(6); PG8_BAR; PG8_MMA(1, 1, At, B1); PG8_BAR;
            }
        }
        if constexpr (ALIGN_EPI) { if (wr == 0) PG8_BAR; }
        if constexpr (!Epi::AFTER_DRAIN) { E(acc, cur, wr, wc, fr, fq); S.done(cur); }
        if (!has_next) break;
#pragma unroll
        for (int a = 0; a < 2; ++a)
#pragma unroll
            for (int b = 0; b < 2; ++b)
#pragma unroll
                for (int m = 0; m < 4; ++m)
#pragma unroll
                    for (int n = 0; n < 2; ++n) acc[a][b][m][n] = (f32x4){0.f, 0.f, 0.f, 0.f};
        cur = nxt; cA = nA; cB = nB; ++ui;
        if constexpr (ALIGN_EPI) { if (wr == 1) PG8_BAR; }
    }
    PG8_WAIT_V(0);
    if constexpr (!ALIGN_EPI) { if (wr == 0) PG8_BAR; }
    PG8_BAR;
    if constexpr (Epi::AFTER_DRAIN) { E.fused(acc, cur, wr, wc, fr, fq, lds, wid, lane); S.done(cur); }
#undef PG8_SA
#undef PG8_SB
#undef PG8_STAGE
#undef PG8_LDA
#undef PG8_LDB
#undef PG8_MMA
#undef PG8_WAIT_V
#undef PG8_WAIT_L
#undef PG8_BAR
#undef PG8_SCHED
}
}

#ifndef PG8_SP2
#define PG8_SP2 true
#endif
#ifndef PG8_ALIGN
#define PG8_ALIGN true
#endif

constexpr int NWAVES = 8;
#ifndef MK_N_LAUNCHES
#define MK_N_LAUNCHES 1
#endif
constexpr int N_PHASES = 7;
#ifndef MK_DUP
#define PEER_PROBE 0
#define PEER_PROBE_U 0
#define PEER_PROBE_MASK 0xffff
#define MK_DUP 0
#endif
constexpr int DUP = MK_DUP;
constexpr int N_LAUNCHES = MK_N_LAUNCHES;

constexpr int BATCH = 4, SEQ = 8192, D = 1024, NMETA = 16;
constexpr int M = BATCH * SEQ;
constexpr int PROJW = 4104, NPROJ = 4096;
constexpr int NEXP = 16384, PEERN = 2048;
constexpr int LPOS = SEQ + NMETA;
constexpr int MPW = 2056;
constexpr float EPS = 1e-6f;
constexpr float KSCALE = 0.08838834764831845f;
constexpr float USCALE = 64.f, VSCALE = 5.656854f, XSCALE = 16.f;

constexpr size_t MiB = 1u << 20;
constexpr size_t WS_CTL = 0, CTL_ZERO_BYTES = 64 * 1024;
constexpr size_t WS_MP = 1 * MiB;
constexpr size_t WS_GS = 1 * MiB + 512 * 1024;
constexpr size_t WS_ROT = 2 * MiB;
constexpr size_t WS_GATES = 7 * MiB;
constexpr size_t WS_WIN = 8 * MiB;
constexpr size_t WS_SSQ = WS_WIN;
constexpr size_t WS_WOUT = 16 * MiB;
constexpr size_t WS_WPEER = 18 * MiB;
constexpr size_t WS_SLOC = 24 * MiB;
constexpr size_t WS_SMETA = 42 * MiB;
constexpr size_t WS_UD = 48 * MiB;
constexpr size_t WS_VU = 80 * MiB;
constexpr size_t WS_XN = 112 * MiB;
constexpr size_t WS_H1B = 176 * MiB;
constexpr size_t WS_PROJ = 240 * MiB;
constexpr size_t WS_END = 496 * MiB;
constexpr size_t STATE_BYTES = 8 * 9 * 64 * 16;
constexpr int CW_BAR = 1024;

constexpr int RING_OFF = 0, RING_BYTES = 131072;
constexpr int LDSCTL_OFF = 148992, MISC_OFF = LDSCTL_OFF + 320;
constexpr int LDS_BYTES = 158720;
constexpr int L_PT = 98304, PT_STRIDE = 144, L_CIMG = 107520, L_NVEC = 140288, L_VEC0 = 140544, L_LNX = 142592, L_GS0 = 146688;

#define GAS __attribute__((address_space(1)))
#define LAS __attribute__((address_space(3)))
typedef unsigned short bf16;
typedef unsigned v4u __attribute__((ext_vector_type(4)));
typedef unsigned v2u __attribute__((ext_vector_type(2)));
typedef float f32x4 __attribute__((ext_vector_type(4)));
typedef float f32x2 __attribute__((ext_vector_type(2)));
typedef short bf16x8 __attribute__((ext_vector_type(8)));
typedef short s16x4 __attribute__((ext_vector_type(4)));
typedef short v4i16_t __attribute__((ext_vector_type(4)));
typedef __bf16 bf16x2_t __attribute__((ext_vector_type(2)));
typedef GAS unsigned gu32;
#define RLX_AGENT __ATOMIC_RELAXED, __HIP_MEMORY_SCOPE_AGENT
#define LDS_WAIT() asm volatile("s_waitcnt lgkmcnt(0)" ::: "memory")
#define VM_WAIT() asm volatile("s_waitcnt vmcnt(0)" ::: "memory")
__device__ __forceinline__ unsigned f2bf(float f) { unsigned u = __builtin_bit_cast(unsigned, f); return (u + 0x7fffu + ((u >> 16) & 1u)) >> 16; }
__device__ __forceinline__ unsigned pk2(float lo, float hi) { const f32x2 v = {lo, hi}; return __builtin_bit_cast(unsigned, __builtin_convertvector(v, bf16x2_t)); }
__device__ __forceinline__ float bflo(unsigned w) { return __builtin_bit_cast(float, w << 16); }
__device__ __forceinline__ float bfhi(unsigned w) { return __builtin_bit_cast(float, w & 0xffff0000u); }
__device__ __forceinline__ float bf2f(short s) { return __builtin_bit_cast(float, ((unsigned)(unsigned short)s) << 16); }
__device__ __forceinline__ unsigned off_a(unsigned row, unsigned ch) { return 2048u * (row >> 3) + 512u * (ch >> 2) + 64u * (row & 7) + 16u * ((ch & 3) ^ ((row >> 2) & 3)); }
__device__ __forceinline__ unsigned lds_row_base(unsigned lane) { const unsigned l15 = lane & 15, g = lane >> 4; return 2048u * (l15 >> 3) + 64u * (l15 & 7) + 16u * (g ^ ((l15 >> 2) & 3)); }
__device__ __forceinline__ unsigned tr_base(unsigned lane, unsigned cpar, unsigned t) { const unsigned g = lane >> 4, q = (lane & 15) >> 2, p = lane & 3;
    return 2048u * g + 64u * q + 8u * (p & 1) + 256u * t + 32u * (cpar ^ (g & 1)) + 16u * ((p >> 1) ^ t); }
__device__ __forceinline__ s16x4 vtr(const LAS unsigned char* p) { return __builtin_bit_cast(s16x4, __builtin_amdgcn_ds_read_tr16_b64_v4i16((LAS v4i16_t*)p)); }
__device__ __forceinline__ bf16x8 cat8(s16x4 lo, s16x4 hi) { return (bf16x8){lo[0], lo[1], lo[2], lo[3], hi[0], hi[1], hi[2], hi[3]}; }
template <int CTRL> __device__ __forceinline__ float dpp_f(float v) { return __builtin_bit_cast(float, __builtin_amdgcn_mov_dpp(__builtin_bit_cast(int, v), CTRL, 0xf, 0xf, false)); }
__device__ __forceinline__ float row_sum16(float v) { v += dpp_f<0xB1>(v); v += dpp_f<0x4E>(v); v += dpp_f<0x141>(v); v += dpp_f<0x140>(v); return v; }
__device__ __forceinline__ float wave_sum(float v) {
    v = row_sum16(v);
    const float a = __builtin_bit_cast(float, __builtin_amdgcn_readlane(__builtin_bit_cast(int, v), 0)), b = __builtin_bit_cast(float, __builtin_amdgcn_readlane(__builtin_bit_cast(int, v), 16));
    const float c = __builtin_bit_cast(float, __builtin_amdgcn_readlane(__builtin_bit_cast(int, v), 32)), d = __builtin_bit_cast(float, __builtin_amdgcn_readlane(__builtin_bit_cast(int, v), 48));
    return (a + b) + (c + d);
}
__device__ __forceinline__ unsigned pack8_fp4(f32x4 a, f32x4 b) { unsigned w = 0u;
    w = __builtin_amdgcn_cvt_scalef32_pk_fp4_f32(w, a.x, a.y, 1.0f, 0); w = __builtin_amdgcn_cvt_scalef32_pk_fp4_f32(w, a.z, a.w, 1.0f, 1);
    w = __builtin_amdgcn_cvt_scalef32_pk_fp4_f32(w, b.x, b.y, 1.0f, 2); w = __builtin_amdgcn_cvt_scalef32_pk_fp4_f32(w, b.z, b.w, 1.0f, 3); return w; }
__device__ __forceinline__ void unpack8_fp4(unsigned w, f32x2 (&p)[4]) {
    p[0] = __builtin_amdgcn_cvt_scalef32_pk_f32_fp4(w, 1.0f, 0); p[1] = __builtin_amdgcn_cvt_scalef32_pk_f32_fp4(w, 1.0f, 1);
    p[2] = __builtin_amdgcn_cvt_scalef32_pk_f32_fp4(w, 1.0f, 2); p[3] = __builtin_amdgcn_cvt_scalef32_pk_f32_fp4(w, 1.0f, 3); }
__device__ __forceinline__ float dot2bf(unsigned w, unsigned x, float acc) { return __builtin_amdgcn_fdot2_f32_bf16(__builtin_bit_cast(bf16x2_t, w), __builtin_bit_cast(bf16x2_t, x), acc, false); }

#define XB_TMO      128
#define XB_XCNT(j)  (256  + 64 * (j))
#define XB_XSUB(j)  (1280 + 64 * (j))
#define XB_XGEN(j)  (2304 + 64 * (j))
#define XB_TOP      3328
#define XB_TOPGEN   3392
#define XCD_BAR_WORDS 3456
#define XB_SPIN_CAP (1u << 22)

__device__ __forceinline__ unsigned xb_ld(unsigned* p)              { return __hip_atomic_load(p, __ATOMIC_RELAXED, __HIP_MEMORY_SCOPE_AGENT); }
__device__ __forceinline__ unsigned xb_add(unsigned* p, unsigned v) { return __hip_atomic_fetch_add(p, v, __ATOMIC_RELAXED, __HIP_MEMORY_SCOPE_AGENT); }
__device__ __forceinline__ unsigned xb_xcc_id() { return (unsigned)__builtin_amdgcn_s_getreg((3 << 11) | 20) & 0xFu; }
#define XB_SPIN(cond, bar) do { unsigned _sp = 0; while (cond) { __builtin_amdgcn_s_sleep(1); \
    if ((++_sp & 255u) == 0u) { if (xb_ld(&(bar)[XB_TMO])) break; if (_sp > XB_SPIN_CAP) { atomicAdd(&(bar)[XB_TMO], 1u); break; } } } } while (0)

struct XcdBarrier {
    unsigned* bar; unsigned x;
    volatile LAS unsigned* st;
};

__device__ __forceinline__ XcdBarrier xcd_barrier_post(unsigned* bar, volatile LAS unsigned* st) {
    XcdBarrier b; b.bar = bar; b.x = xb_xcc_id(); b.st = st;
    if (threadIdx.x == 0) (void)xb_add(&bar[XB_XCNT(b.x)], 1u);
    return b;
}
__device__ __forceinline__ void xcd_barrier_complete(unsigned* bar, unsigned x, unsigned& nloc, unsigned& nx) {
    const unsigned G = gridDim.x * gridDim.y * gridDim.z;
    unsigned sum, cnt, mine, sp = 0u;
    for (;;) {
        sum = 0u; cnt = 0u; mine = 0u;
#pragma unroll
        for (unsigned j = 0; j < 16; ++j) { const unsigned c = xb_ld(&bar[XB_XCNT(j)]); sum += c; cnt += (c > 0u) ? 1u : 0u; mine = (j == x) ? c : mine; }
        if (sum == G) break;
        __builtin_amdgcn_s_sleep(1);
        if ((++sp & 255u) == 0u) { if (xb_ld(&bar[XB_TMO])) break; if (sp > XB_SPIN_CAP) { atomicAdd(&bar[XB_TMO], 1u); break; } }
    }
    nloc = mine > 0u ? mine : 1u; nx = cnt > 0u ? cnt : 1u;
}

__device__ __forceinline__ void xcd_barrier(const XcdBarrier& b) {
    asm volatile("s_waitcnt vmcnt(0)" ::: "memory");
    __syncthreads();
    if (threadIdx.x == 0) {
        unsigned* bar = b.bar;
        __builtin_amdgcn_s_waitcnt(0);
        unsigned nloc = b.st[0], nx = b.st[1];
        if (nloc == 0u) { xcd_barrier_complete(bar, b.x, nloc, nx); b.st[0] = nloc; b.st[1] = nx; }
        const unsigned old = xb_add(&bar[XB_XSUB(b.x)], 1u);
        const unsigned gen = old / nloc;
        if (old + 1u == (gen + 1u) * nloc) {
            __builtin_amdgcn_fence(__ATOMIC_RELEASE, "agent");
            asm volatile("s_waitcnt vmcnt(0)" ::: "memory");
            const unsigned og = xb_add(&bar[XB_TOP], 1u);
            const unsigned tg = og / nx;
            if (og + 1u == (tg + 1u) * nx) xb_add(&bar[XB_TOPGEN], 1u);
            else XB_SPIN(xb_ld(&bar[XB_TOPGEN]) == tg, bar);
            __builtin_amdgcn_fence(__ATOMIC_ACQUIRE, "agent");
            xb_add(&bar[XB_XGEN(b.x)], 1u);
            asm volatile("s_waitcnt vmcnt(0)" ::: "memory");
        } else {
            XB_SPIN(xb_ld(&bar[XB_XGEN(b.x)]) == gen, bar);
            __builtin_amdgcn_fence(__ATOMIC_ACQUIRE, "agent");
            asm volatile("s_waitcnt vmcnt(0)" ::: "memory");
        }
    }
    __syncthreads();
}

struct Args {
    const float* x; const float* meta; const float* norm1_w; const float* w_in; const float* gate_bias; const float* m_norm_w; const float* r_norm_w; const float* w_out;
    const float* norm2_w; const float* w_query; const float* sub_keys; const float* w_down; const float* w_up; const float* final_w;
    float* out; unsigned char* ws; float fzero; int imask; int izero;
};
struct Ctx { LAS unsigned char* lds; int tid, lane, wave, vcu, G; };
__device__ __forceinline__ Ctx fresh_ctx(const Ctx& C0) { Ctx C = C0; int t = C0.tid; asm volatile("" : "+v"(t)); C.tid = t; C.lane = t & 63; C.wave = __builtin_amdgcn_readfirstlane(t >> 6); return C; }

__device__ __forceinline__ int mp_src_col(int mc) { return mc < 512 ? 512 + mc : mc < 1024 ? 1024 + (mc - 512) : mc < 1536 ? 2560 + (mc - 1024) : mc < 2048 ? 3072 + (mc - 1536) : 4096 + (mc - 2048); }
__device__ __forceinline__ int win_dest_row(int o) {
    if (o < 2048 || o >= 3072) return o;
    const int base = o & ~127, d = o & 127;
    return base + (d < 64 ? 8 * (d >> 2) + (d & 3) : 8 * ((d - 64) >> 2) + 4 + (d & 3));
}
template <int MODE>
__device__ __forceinline__ void p0_transpose_item(const float* W, int K, int ldn, int N, bf16* WT, LAS float* scr, int item, int lane, const float* gain, const float* gain2) {
    const int nblk = N / 32, kb = item / nblk, nb = item % nblk, k0 = 64 * kb, n0 = 32 * nb;
    float cs = 1.f;
    if (MODE == 1) { const int o = n0 + (lane & 31); cs = ((o >= 512 && o < 1024) || (o >= 2560 && o < 3072)) ? KSCALE : 1.f; }
#pragma unroll 8
    for (int i = 0; i < 32; ++i) { const int kk = 2 * i + (lane >> 5); float v = W[(size_t)(k0 + kk) * ldn + n0 + (lane & 31)];
        if (MODE == 1) v *= gain[k0 + kk] * cs;
        if (MODE == 2) v *= (k0 + kk < 512) ? gain[k0 + kk] : gain2[k0 + kk - 512];
        scr[kk * 33 + (lane & 31)] = v; }
    LDS_WAIT(); asm volatile("" ::: "memory");
    const int c = lane & 7;
#pragma unroll
    for (int j = 0; j < 4; ++j) { const int n = (lane >> 3) + 8 * j; const LAS float* s = scr + (8 * c) * 33 + n;
        v4u o; o.x = pk2(s[0 * 33], s[1 * 33]); o.y = pk2(s[2 * 33], s[3 * 33]); o.z = pk2(s[4 * 33], s[5 * 33]); o.w = pk2(s[6 * 33], s[7 * 33]);
        const int drow = (MODE == 1) ? win_dest_row(n0 + n) : (n0 + n);
        *(GAS v4u*)(WT + (size_t)drow * K + k0 + 8 * c) = o; }
    LDS_WAIT(); asm volatile("" ::: "memory");
}

__device__ __forceinline__ void p0_prep(const Args& A, const Ctx& C) {
    unsigned char* ws = A.ws;
    const int tid = C.tid, lane = C.lane, wave = C.wave;
    const int gw = C.vcu * NWAVES + wave, NGW = C.G * NWAVES;
    const int gt = C.vcu * 512 + tid, NGT = C.G * 512;
    {
        constexpr int AMS = 1028;
        LAS float* AM = (LAS float*)(C.lds);
        LAS float* RED = (LAS float*)(C.lds + 16 * AMS * 4);
        constexpr int NIT = (MPW + 15) / 16;
        if (C.vcu < NIT) {
            for (int rr = 0; rr < 2; ++rr) { const int r = wave * 2 + rr; const float* mr = A.meta + (size_t)r * D;
                f32x4 v[4]; float s = 0.f;
#pragma unroll
                for (int j = 0; j < 4; ++j) { v[j] = *(const f32x4*)(mr + 4 * lane + 256 * j); s += (v[j].x * v[j].x + v[j].y * v[j].y) + (v[j].z * v[j].z + v[j].w * v[j].w); }
                const float rstd = 1.f / sqrtf(wave_sum(s) * (1.f / D) + EPS);
#pragma unroll
                for (int j = 0; j < 4; ++j) { const f32x4 g = *(const f32x4*)(A.norm1_w + 4 * lane + 256 * j); *(LAS f32x4*)(AM + r * AMS + 4 * lane + 256 * j) = v[j] * rstd * g; }
            }
        }
        __syncthreads();
        float* mp = (float*)(ws + WS_MP);
        for (int it = C.vcu; it < NIT; it += C.G) {
            const int mc0 = 16 * it, sc0 = mp_src_col(mc0), j16 = lane & 15, kq = lane >> 4;
            const bool colok = mc0 + j16 < MPW;
            const float* wp = A.w_in + (size_t)(128 * wave + kq) * PROJW + sc0 + j16;
            const LAS float* ap = AM + j16 * AMS + 128 * wave + kq;
            f32x4 acc = (f32x4){0.f, 0.f, 0.f, 0.f};
#pragma unroll 8
            for (int s4 = 0; s4 < 32; ++s4) {
                const float b = colok ? wp[(size_t)(4 * s4) * PROJW] : 0.f;
                acc = __builtin_amdgcn_mfma_f32_16x16x4f32(ap[4 * s4], b, acc, 0, 0, 0); }
#pragma unroll
            for (int r4 = 0; r4 < 4; ++r4) RED[wave * 256 + (4 * kq + r4) * 16 + j16] = acc[r4];
            __syncthreads();
            if (tid < 256) { float sum = 0.f;
#pragma unroll
                for (int w8 = 0; w8 < 8; ++w8) sum += RED[w8 * 256 + tid];
                const int r = tid >> 4, mc = mc0 + (tid & 15);
                if (mc < MPW) { if (mc >= 2048) sum += A.gate_bias[mc - 2048]; mp[r * MPW + mc] = sum; } }
            __syncthreads();
        }
        __syncthreads();
    }
    {
        bf16* WP = (bf16*)(ws + WS_WPEER);
        const int l16 = lane & 15, kg = lane >> 4;
        auto split8 = [](const f32x4 a, const f32x4 b, bf16x8& hi, bf16x8& lo) {
            const float x[8] = {a.x, a.y, a.z, a.w, b.x, b.y, b.z, b.w};
#pragma unroll
            for (int e = 0; e < 8; e += 2) { const unsigned h = pk2(x[e], x[e + 1]); const unsigned l = pk2(x[e] - bflo(h), x[e + 1] - bfhi(h));
                hi[e] = (short)(h & 0xffffu); hi[e + 1] = (short)(h >> 16); lo[e] = (short)(l & 0xffffu); lo[e + 1] = (short)(l >> 16); } };
        for (int it = C.vcu; it < 256; it += C.G) {
            const int hp = it >> 4, kb = it & 15, p = hp & 1;
            const float* krow = A.sub_keys + (size_t)p * 128 * 128 + (size_t)(16 * wave + l16) * 128 + 8 * kg;
            bf16x8 kh[4], kl[4];
#pragma unroll
            for (int s4 = 0; s4 < 4; ++s4) split8(*(const f32x4*)(krow + 32 * s4), *(const f32x4*)(krow + 32 * s4 + 4), kh[s4], kl[s4]);
#pragma unroll
            for (int kt = 0; kt < 4; ++kt) {
                const float* qrow = A.w_query + (size_t)(kb * 64 + kt * 16 + l16) * PEERN + hp * 128 + 8 * kg;
                f32x4 acc = (f32x4){0.f, 0.f, 0.f, 0.f};
#pragma unroll
                for (int s4 = 0; s4 < 4; ++s4) { bf16x8 ah, al; split8(*(const f32x4*)(qrow + 32 * s4), *(const f32x4*)(qrow + 32 * s4 + 4), ah, al);
                    acc = __builtin_amdgcn_mfma_f32_16x16x32_bf16(ah, kh[s4], acc, 0, 0, 0);
                    acc = __builtin_amdgcn_mfma_f32_16x16x32_bf16(ah, kl[s4], acc, 0, 0, 0);
                    acc = __builtin_amdgcn_mfma_f32_16x16x32_bf16(al, kh[s4], acc, 0, 0, 0); }
                const int k0 = kb * 64 + kt * 16 + 4 * kg; const f32x4 g2 = *(const f32x4*)(A.norm2_w + k0);
                v2u o; o.x = pk2(acc[0] * g2.x, acc[1] * g2.y); o.y = pk2(acc[2] * g2.z, acc[3] * g2.w);
                *(GAS v2u*)(WP + (size_t)(hp * 128 + 16 * wave + l16) * D + k0) = o;
            }
        }
    }
    {
        LAS float* scr = (LAS float*)(C.lds + wave * 16384);
        constexpr int I_IN = (D / 64) * (NPROJ / 32), I_OUT = (D / 64) * (D / 32);
        for (int it = gw; it < I_IN + I_OUT; it += NGW) {
            if (it < I_IN) p0_transpose_item<1>(A.w_in, D, PROJW, NPROJ, (bf16*)(ws + WS_WIN), scr, it, lane, A.norm1_w, nullptr);
            else p0_transpose_item<2>(A.w_out, D, D, D, (bf16*)(ws + WS_WOUT), scr, it - I_IN, lane, A.m_norm_w, A.r_norm_w);
        }
    }
    {
        float* rot = (float*)(ws + WS_ROT);
        const int f = gt & 63; const double inv = exp(-(double)f * (9.210340371976184 / 64.0));
        for (int i = gt; i < LPOS * 64; i += NGT) { const int pos = i >> 6;
            const double ang = (double)pos * inv; const double kq = rint(ang * 0.15915494309189535);
            const float r = (float)fma(-kq, 6.283185307179586, ang);
            rot[(size_t)pos * 128 + f] = cosf(r); rot[(size_t)pos * 128 + 64 + f] = sinf(r); }
    }
    {
        bf16* XN = (bf16*)(ws + WS_XN); float* GT = (float*)(ws + WS_GATES);
        LAS float* WG = (LAS float*)(C.lds);
        __syncthreads();
        for (int i = tid; i < 2048; i += 512) { const int k = i >> 1, h4 = 4 * (i & 1);
            *(LAS f32x4*)(WG + k * 8 + h4) = *(const f32x4*)(A.w_in + (size_t)k * PROJW + 4096 + h4) * A.norm1_w[k]; }
        __syncthreads();
        float wg[4][4][8];
#pragma unroll
        for (int j = 0; j < 4; ++j)
#pragma unroll
            for (int e = 0; e < 4; ++e) { const int k = 4 * lane + 256 * j + e;
                const f32x4 w0 = *(const LAS f32x4*)(WG + k * 8), w1 = *(const LAS f32x4*)(WG + k * 8 + 4);
                wg[j][e][0] = w0.x; wg[j][e][1] = w0.y; wg[j][e][2] = w0.z; wg[j][e][3] = w0.w;
                wg[j][e][4] = w1.x; wg[j][e][5] = w1.y; wg[j][e][6] = w1.z; wg[j][e][7] = w1.w; }
        const float gb = A.gate_bias[lane & 7];
        f32x4 nv[4];
#pragma unroll
        for (int j = 0; j < 4; ++j) nv[j] = (gw < M) ? *(const f32x4*)(A.x + (size_t)gw * D + 4 * lane + 256 * j) : (f32x4){0.f, 0.f, 0.f, 0.f};
        for (int m = gw; m < M; m += NGW) {
            f32x4 v[4]; float s = 0.f;
#pragma unroll
            for (int j = 0; j < 4; ++j) v[j] = nv[j];
            if (m + NGW < M) {
#pragma unroll
                for (int j = 0; j < 4; ++j) nv[j] = *(const f32x4*)(A.x + (size_t)(m + NGW) * D + 4 * lane + 256 * j); }
#pragma unroll
            for (int j = 0; j < 4; ++j) { s += (v[j].x * v[j].x + v[j].y * v[j].y) + (v[j].z * v[j].z + v[j].w * v[j].w); }
            const float rstd = 1.f / sqrtf(wave_sum(s) * (1.f / D) + EPS);
            float gd[8];
#pragma unroll
            for (int q = 0; q < 8; ++q) gd[q] = 0.f;
#pragma unroll
            for (int j = 0; j < 4; ++j)
#pragma unroll
                for (int e = 0; e < 4; ++e)
#pragma unroll
                    for (int q = 0; q < 8; ++q) gd[q] += v[j][e] * wg[j][e][q];
            float mine = 0.f;
#pragma unroll
            for (int q = 0; q < 8; ++q) { const float t = wave_sum(gd[q]); mine = ((lane & 7) == q) ? t : mine; }
            if (lane < 8) GT[(size_t)m * 8 + lane] = mine * rstd + gb;
            GAS unsigned long long* o8 = (GAS unsigned long long*)(XN + (size_t)m * D) + lane;
#pragma unroll
            for (int j = 0; j < 4; ++j) o8[64 * j] = (unsigned long long)pk2(v[j].x * rstd, v[j].y * rstd) | ((unsigned long long)pk2(v[j].z * rstd, v[j].w * rstd) << 32);
        }
    }
}

__device__ __forceinline__ float logsigf(float f) { return f >= 0.f ? -__logf(1.f + __expf(-f)) : f - __logf(1.f + __expf(f)); }
__device__ __forceinline__ float wave_scan64(float v) {
    v += __builtin_bit_cast(float, __builtin_amdgcn_update_dpp(0, __builtin_bit_cast(int, v), 0x111, 0xf, 0xf, true));
    v += __builtin_bit_cast(float, __builtin_amdgcn_update_dpp(0, __builtin_bit_cast(int, v), 0x112, 0xf, 0xf, true));
    v += __builtin_bit_cast(float, __builtin_amdgcn_update_dpp(0, __builtin_bit_cast(int, v), 0x114, 0xf, 0xf, true));
    v += __builtin_bit_cast(float, __builtin_amdgcn_update_dpp(0, __builtin_bit_cast(int, v), 0x118, 0xf, 0xf, true));
    v += __builtin_bit_cast(float, __builtin_amdgcn_update_dpp(0, __builtin_bit_cast(int, v), 0x142, 0xa, 0xf, false));
    v += __builtin_bit_cast(float, __builtin_amdgcn_update_dpp(0, __builtin_bit_cast(int, v), 0x143, 0xc, 0xf, false));
    return v;
}

template <bool FULL>
__device__ __forceinline__ void mixer_item(const Args& A, const Ctx& C, int item) {
    unsigned char* ws = A.ws;
    LAS unsigned char* lds = C.lds;
    const int tid = C.tid, lane = C.lane, w = C.wave, g4 = lane >> 4, l15 = lane & 15, tw = w >> 1, vh = w & 1;
    const int chain = item >> 3, grp = item & 7, b = chain >> 3, hh = chain & 7, hl = hh & 3;
    const bool isR = hh >= 4;
    const int qcol = (hh >> 2) * 2048 + 128 * hl, kcol = qcol + 512, vcol = qcol + 1024, ocol = qcol + 1536;
    const int row_base = b * SEQ + grp * 1024;
    const bf16* PROJ = (const bf16*)(ws + WS_PROJ);
    const float* GATES = (const float*)(ws + WS_GATES);
    const float lgam = log1pf(-exp2f(-5.f - (float)hl));
    f32x4* SL = (f32x4*)(ws + WS_SLOC); f32x4* SM = (f32x4*)(ws + WS_SMETA);
    float* GSUM = (float*)(ws + WS_GS);

    f32x4 accC[9];
#pragma unroll
    for (int nb = 0; nb < 9; ++nb) accC[nb] = (f32x4){0.f, 0.f, 0.f, 0.f};
    float gsum = 0.f;
    f32x4 sjw[4], sjg[4];
    const unsigned rwb = lds_row_base(lane);
    const unsigned rb_q = rwb + 4096u * tw, rb_k = rwb + 4096u * vh, rb_c = rwb + 16384u * vh;
    const unsigned trb00 = tr_base(lane, 0, 0), trb01 = tr_base(lane, 0, 1), trb10 = tr_base(lane, 1, 0), trb11 = tr_base(lane, 1, 1);
    const unsigned trk0 = ((w & 1) ? trb10 : trb00) + 512u * (w >> 1), trk1 = ((w & 1) ? trb11 : trb01) + 512u * (w >> 1);
    const unsigned cimg_w = off_a(l15, 2 * w + (g4 >> 1)) + 8 * (g4 & 1);
    const unsigned tile_o = off_a(tid >> 4, tid & 15);
#define TRV(c_, ks_, t_) ((((c_) & 1) ? ((t_) ? trb11 : trb10) : ((t_) ? trb01 : trb00)) + 8192u * (ks_) + 512u * ((c_) >> 1))
#define L_QT(b_) ((b_) * 49152)
#define L_PTB(b_) ((b_) ? 149504 : L_PT)
#define L_KT(b_) ((b_) * 49152 + 16384)
#define L_VT(b_) ((b_) * 49152 + 32768)
#define L_VEC(b_) (L_VEC0 + (b_) * 1024)
#define L_GS(b_) (L_GS0 + (b_) * 16)

    if (FULL) {
        if (grp == 0) {
#pragma unroll
            for (int nb = 0; nb < 9; ++nb) accC[nb] = SM[(size_t)chain * (STATE_BYTES / 16) + (w * 9 + nb) * 64 + lane];
        } else {
            float dec = 0.f;
            for (int gp = grp - 1; gp >= 0; --gp) {
                const float cf = __expf(dec);
#pragma unroll
                for (int nb = 0; nb < 9; ++nb) accC[nb] += SL[(size_t)(chain * 8 + gp) * (STATE_BYTES / 16) + (w * 9 + nb) * 64 + lane] * cf;
                dec += GSUM[chain * 8 + gp];
            }
        }
#pragma unroll
        for (int nb = 0; nb < 8; ++nb) { v2u o; o.x = pk2(accC[nb][0], accC[nb][1]); o.y = pk2(accC[nb][2], accC[nb][3]);
            *(LAS v2u*)(lds + L_CIMG + cimg_w + 4096 * nb) = o; }
        if (l15 == 0) { v2u o; o.x = pk2(accC[8][0], accC[8][1]); o.y = pk2(accC[8][2], accC[8][3]); *(LAS v2u*)(lds + L_NVEC + (16 * w + 4 * g4) * 2) = o; }
    }

    constexpr int PD = FULL ? 1 : 4;
    v4u pq[PD][2], pk[PD][2], pv[PD][2]; float gi[PD], gf[PD];
#define MX_PREFETCH(u_, c_) do { _Pragma("unroll") for (int i_ = 0; i_ < 2; ++i_) { const int p_ = tid + 512 * i_, r_ = p_ >> 4, ch_ = p_ & 15; const bf16* rp_ = PROJ + (size_t)(row_base + 64 * (c_) + r_) * NPROJ + 8 * ch_; \
            if (FULL) pq[u_][i_] = *(const v4u*)(rp_ + qcol); \
            pk[u_][i_] = *(const v4u*)(rp_ + kcol); pv[u_][i_] = *(const v4u*)(rp_ + vcol); } \
        if (w == 0 && !isR) { const float* gp_ = GATES + (size_t)(row_base + 64 * (c_) + lane) * 8; gi[u_] = gp_[hl]; gf[u_] = gp_[4 + hl]; } } while (0)
#define MX_STAGE_TILES(u_, b_) do { _Pragma("unroll") for (int i_ = 0; i_ < 2; ++i_) { const unsigned o_ = tile_o + 8192u * i_; \
            if (FULL) *(LAS v4u*)(lds + L_QT(b_) + o_) = pq[u_][i_]; \
            *(LAS v4u*)(lds + L_KT(b_) + o_) = pk[u_][i_]; *(LAS v4u*)(lds + L_VT(b_) + o_) = pv[u_][i_]; } } while (0)
#define MX_VECTORS(li__, lf__, b_) do { if (w == 0) { const float bs_ = wave_scan64(lf__); \
            const float gc_ = __builtin_bit_cast(float, __builtin_amdgcn_readlane(__builtin_bit_cast(int, bs_), 63)), aj_ = (li__) - bs_; LAS float* vb_ = (LAS float*)(lds + L_VEC(b_)); \
            vb_[lane] = bs_; vb_[64 + lane] = aj_; vb_[128 + lane] = __expf(gc_ + aj_); vb_[192 + lane] = __expf(bs_); \
            if (lane == 0) *(LAS float*)(lds + L_GS(b_)) = gc_; } } while (0)

    auto step1 = [&](auto TNT) {
        constexpr int TN = decltype(TNT)::value;
        LAS float* bvec = (LAS float*)(lds + L_VEC(TN)); LAS float* avec = bvec + 64;
        bf16x8 qf[4];
#pragma unroll
        for (int s = 0; s < 4; ++s) qf[s] = *(const LAS bf16x8*)(lds + L_QT(TN) + rb_q + 512 * s);
        const int t = 16 * tw + l15; const float bt = bvec[t];
#pragma unroll
        for (int jj = 0; jj < 2; ++jj) { const int jt = vh + 2 * jj;
            f32x4 sacc = (f32x4){0.f, 0.f, 0.f, 0.f};
#pragma unroll
            for (int s = 0; s < 4; ++s) { const bf16x8 kf = *(const LAS bf16x8*)(lds + L_KT(TN) + rb_k + 8192 * jj + 512 * s); sacc = __builtin_amdgcn_mfma_f32_16x16x32_bf16(kf, qf[s], sacc, 0, 0, 0); }
            const int j0 = 16 * jt + 4 * g4; const f32x4 a4 = *(const LAS f32x4*)(avec + j0);
            float pr[4];
#pragma unroll
            for (int r = 0; r < 4; ++r) pr[r] = (j0 + r <= t) ? sacc[r] * __expf(bt + a4[r]) : 0.f;
            v2u o; o.x = pk2(pr[0], pr[1]); o.y = pk2(pr[2], pr[3]);
            *(LAS v2u*)(lds + L_PTB(TN) + t * PT_STRIDE + j0 * 2) = o; }
    };

    auto body = [&](auto UT, auto MT, const int c) {
        constexpr int U = decltype(UT)::value; constexpr bool META = decltype(MT)::value;
        constexpr int TB = FULL ? U : 0;
        if constexpr (FULL) {
            if (c + 2 < 16) MX_PREFETCH(0, c + 2);
        } else if constexpr (!META) {
            MX_STAGE_TILES(U, 0); MX_VECTORS(isR ? 0.f : gi[U], isR ? lgam : logsigf(gf[U]), 0);
            __syncthreads();
            if (c + PD < 16) MX_PREFETCH(U, c + PD);
            {
                const int R = item * 8 + w + 2048 * (c >> 1); const float* src = ((c & 1) ? A.w_up : A.w_down) + (size_t)R * D + 4 * lane;
#pragma unroll
                for (int j = 0; j < 4; ++j) { sjw[j] = *(const f32x4*)(src + 256 * j); if (!(c & 1)) sjg[j] = *(const f32x4*)(A.norm2_w + 256 * j + 4 * lane); }
            }
        } else {
            const float* mp = (const float*)(ws + WS_MP); const float* rot = (const float*)(ws + WS_ROT);
#pragma unroll
            for (int i = 0; i < 2; ++i) { const int p = tid + 512 * i, r = p >> 4, ch = p & 15; const unsigned o = tile_o + 8192u * i;
                v4u kq = (v4u){0u, 0u, 0u, 0u}, vq = kq;
                if (r >= 48) { const int mr = r - 48; const float* mrow = mp + mr * MPW;
                    float kv[8], vv[8];
                    if (!isR) {
#pragma unroll
                        for (int e = 0; e < 8; ++e) { kv[e] = mrow[128 * hl + 8 * ch + e] * KSCALE; vv[e] = mrow[512 + 128 * hl + 8 * ch + e]; }
                    } else {
#pragma unroll
                        for (int e = 0; e < 4; ++e) { const float x1 = mrow[1024 + 128 * hl + 4 * ch + e], x2 = mrow[1024 + 128 * hl + 64 + 4 * ch + e];
                            const float cs = rot[mr * 128 + 4 * ch + e], sn = rot[mr * 128 + 64 + 4 * ch + e];
                            kv[e] = (x1 * cs - x2 * sn) * KSCALE; kv[4 + e] = (x1 * sn + x2 * cs) * KSCALE; }
#pragma unroll
                        for (int e = 0; e < 8; ++e) vv[e] = mrow[1536 + 128 * hl + 8 * ch + e];
                    }
                    kq.x = pk2(kv[0], kv[1]); kq.y = pk2(kv[2], kv[3]); kq.z = pk2(kv[4], kv[5]); kq.w = pk2(kv[6], kv[7]);
                    vq.x = pk2(vv[0], vv[1]); vq.y = pk2(vv[2], vv[3]); vq.z = pk2(vv[4], vv[5]); vq.w = pk2(vv[6], vv[7]);
                }
                *(LAS v4u*)(lds + L_KT(0) + o) = kq; *(LAS v4u*)(lds + L_VT(0) + o) = vq; }
            float li_ = 0.f, lf_ = 0.f;
            if (lane >= 48) { const float* mrow = mp + (lane - 48) * MPW + 2048; li_ = isR ? 0.f : mrow[hl]; lf_ = isR ? lgam : logsigf(mrow[4 + hl]); }
            MX_VECTORS(li_, lf_, 0);
            __syncthreads();
        }
        LAS float* bvec = (LAS float*)(lds + L_VEC(TB)); LAS float* avec = bvec + 64; LAS float* wvec = bvec + 128; LAS float* ebvec = bvec + 192;
        const float gch = *(LAS float*)(lds + L_GS(TB));
        if constexpr (!META) gsum += gch;
        v2u gqc[4];
#pragma unroll
        for (int vi = 0; vi < 4; ++vi) gqc[vi] = (v2u){0u, 0u};
        if constexpr (FULL) { const bf16* gr_ = PROJ + (size_t)(row_base + 64 * c + 16 * tw + l15) * NPROJ + ocol + 64 * vh + 4 * g4;
#pragma unroll
            for (int vi = 0; vi < 4; ++vi) gqc[vi] = *(const v2u*)(gr_ + 16 * vi); }

        f32x4 acc_o[5];
        if constexpr (FULL) {
            bf16x8 qf[4];
#pragma unroll
            for (int s = 0; s < 4; ++s) qf[s] = *(const LAS bf16x8*)(lds + L_QT(TB) + rb_q + 512 * s);
            const int t = 16 * tw + l15;
#pragma unroll
            for (int vi = 0; vi < 4; ++vi) { f32x4 a = (f32x4){0.f, 0.f, 0.f, 0.f};
#pragma unroll
                for (int s = 0; s < 4; ++s) { const bf16x8 cf = *(const LAS bf16x8*)(lds + L_CIMG + rb_c + 4096 * vi + 512 * s); a = __builtin_amdgcn_mfma_f32_16x16x32_bf16(cf, qf[s], a, 0, 0, 0); }
                acc_o[vi] = a; }
            { f32x4 a = (f32x4){0.f, 0.f, 0.f, 0.f};
#pragma unroll
                for (int s = 0; s < 4; ++s) { bf16x8 nf = *(const LAS bf16x8*)(lds + L_NVEC + (32 * s + 8 * g4) * 2); if (l15 != 0) nf = (bf16x8){0, 0, 0, 0, 0, 0, 0, 0};
                    a = __builtin_amdgcn_mfma_f32_16x16x32_bf16(nf, qf[s], a, 0, 0, 0); }
                acc_o[4] = a; }
            const float eb = ebvec[t];
#pragma unroll
            for (int vi = 0; vi < 5; ++vi) acc_o[vi] *= eb;
        }
        {
            const float eg = __expf(gch);
#pragma unroll
            for (int nb = 0; nb < 9; ++nb) accC[nb] *= eg;
#pragma unroll
            for (int ks = 0; ks < 2; ++ks) {
                const s16x4 klo = vtr(lds + L_KT(TB) + trk0 + 8192 * ks), khi = vtr(lds + L_KT(TB) + trk1 + 8192 * ks);
                const f32x4 w0 = *(const LAS f32x4*)(wvec + 32 * ks + 8 * g4), w1 = *(const LAS f32x4*)(wvec + 32 * ks + 8 * g4 + 4);
                v4u ap; ap.x = pk2(bf2f(klo[0]) * w0[0], bf2f(klo[1]) * w0[1]); ap.y = pk2(bf2f(klo[2]) * w0[2], bf2f(klo[3]) * w0[3]);
                ap.z = pk2(bf2f(khi[0]) * w1[0], bf2f(khi[1]) * w1[1]); ap.w = pk2(bf2f(khi[2]) * w1[2], bf2f(khi[3]) * w1[3]);
                const bf16x8 af = __builtin_bit_cast(bf16x8, ap);
#pragma unroll
                for (int nb = 0; nb < 8; ++nb) { const s16x4 vlo = vtr(lds + L_VT(TB) + TRV(nb, ks, 0)), vhi = vtr(lds + L_VT(TB) + TRV(nb, ks, 1));
                    accC[nb] = __builtin_amdgcn_mfma_f32_16x16x32_bf16(af, cat8(vlo, vhi), accC[nb], 0, 0, 0); }
                const short one = (l15 == 0) ? (short)0x3F80 : (short)0;
                accC[8] = __builtin_amdgcn_mfma_f32_16x16x32_bf16(af, (bf16x8){one, one, one, one, one, one, one, one}, accC[8], 0, 0, 0);
            }
        }
        if constexpr (!FULL) {
            if constexpr (META) {
#pragma unroll
                for (int nb = 0; nb < 9; ++nb) SM[(size_t)chain * (STATE_BYTES / 16) + (w * 9 + nb) * 64 + lane] = accC[nb];
            }
            if constexpr (!META) {
                const int R = item * 8 + w + 2048 * (c >> 1);
                unsigned char* dst = ws + ((c & 1) ? WS_VU : WS_UD) + (size_t)R * (D / 2);
#pragma unroll
                for (int j = 0; j < 4; ++j) { const int q = 64 * j + lane;
                    const f32x4 vs = (c & 1) ? sjw[j] * VSCALE : sjw[j] * sjg[j] * USCALE; unsigned wv = 0u;
                    wv = __builtin_amdgcn_cvt_scalef32_pk_fp4_f32(wv, vs.x, vs.y, 1.0f, 0); wv = __builtin_amdgcn_cvt_scalef32_pk_fp4_f32(wv, vs.z, vs.w, 1.0f, 1);
                    const int bo = (c & 1) ? (16 * (q >> 3) + 4 * (q & 3) + 2 * ((q >> 2) & 1)) : 2 * q;
                    *(GAS unsigned short*)(dst + bo) = (unsigned short)wv; }
            }
            __syncthreads();
        } else {
            __syncthreads();
            if (c + 1 < 16) step1(std::integral_constant<int, TB ^ 1>{});
            {
                const int nks = (tw >> 1) + 1;
#pragma unroll
                for (int ks = 0; ks < 2; ++ks) if (ks < nks) {
                    const bf16x8 pf = *(const LAS bf16x8*)(lds + L_PTB(TB) + (16 * tw + l15) * PT_STRIDE + (32 * ks + 8 * g4) * 2);
#pragma unroll
                    for (int vi = 0; vi < 4; ++vi) {
                        const s16x4 vlo = vtr(lds + L_VT(TB) + 1024u * vh + TRV(vi, ks, 0)), vhi = vtr(lds + L_VT(TB) + 1024u * vh + TRV(vi, ks, 1));
                        acc_o[vi] = __builtin_amdgcn_mfma_f32_16x16x32_bf16(cat8(vlo, vhi), pf, acc_o[vi], 0, 0, 0); }
                    const short one = (l15 == 0) ? (short)0x3F80 : (short)0;
                    acc_o[4] = __builtin_amdgcn_mfma_f32_16x16x32_bf16((bf16x8){one, one, one, one, one, one, one, one}, pf, acc_o[4], 0, 0, 0);
                }
            }
#pragma unroll
            for (int nb = 0; nb < 8; ++nb) { v2u o; o.x = pk2(accC[nb][0], accC[nb][1]); o.y = pk2(accC[nb][2], accC[nb][3]);
                *(LAS v2u*)(lds + L_CIMG + cimg_w + 4096 * nb) = o; }
            if (l15 == 0) { v2u o; o.x = pk2(accC[8][0], accC[8][1]); o.y = pk2(accC[8][2], accC[8][3]); *(LAS v2u*)(lds + L_NVEC + (16 * w + 4 * g4) * 2) = o; }
            {
                const int t = 16 * tw + l15; const int row = row_base + 64 * c + t;
                float z[4][4];
                const float den = __shfl(acc_o[4][0], l15);
                const float inv = isR ? 1.f : __builtin_amdgcn_rcpf(fmaxf(fabsf(den), 1.f));
                float s1 = 0.f, s2 = 0.f;
#pragma unroll
                for (int vi = 0; vi < 4; ++vi) { const v2u gv = gqc[vi]; const float g_[4] = {bflo(gv.x), bfhi(gv.x), bflo(gv.y), bfhi(gv.y)};
#pragma unroll
                    for (int r = 0; r < 4; ++r) { float zz = acc_o[vi][r] * inv; if (!isR) zz *= __builtin_amdgcn_rcpf(1.f + __expf(-g_[r])); z[vi][r] = zz; s1 += zz; s2 += zz * zz; } }
                LAS f32x2* lnx = (LAS f32x2*)(lds + L_LNX);
                lnx[t * 8 + vh * 4 + g4] = (f32x2){s1, s2};
                __syncthreads();
                if (c + 2 < 16) { MX_STAGE_TILES(0, TB); MX_VECTORS(isR ? 0.f : gi[0], isR ? lgam : logsigf(gf[0]), TB); }
                float t1 = 0.f, t2 = 0.f;
#pragma unroll
                for (int q = 0; q < 4; ++q) { const f32x4 pq_ = *(const LAS f32x4*)(lds + L_LNX + t * 64 + q * 16); t1 += pq_.x + pq_.z; t2 += pq_.y + pq_.w; }
                const float mean = t1 * (1.f / 128.f); const float var = fmaxf(t2 * (1.f / 128.f) - mean * mean, 0.f);
                const float rs = __builtin_amdgcn_rsqf(var + EPS);
                bf16* yrow = (bf16*)(ws + WS_XN) + (size_t)row * D + hh * 128 + 64 * vh + 4 * g4;
#pragma unroll
                for (int vi = 0; vi < 4; ++vi) { float yv[4]; const v2u gv = gqc[vi]; const float g_[4] = {bflo(gv.x), bfhi(gv.x), bflo(gv.y), bfhi(gv.y)};
#pragma unroll
                    for (int r = 0; r < 4; ++r) { float y = (z[vi][r] - mean) * rs; if (isR) { const float gg = g_[r]; y *= gg * __builtin_amdgcn_rcpf(1.f + __expf(-gg)); } yv[r] = y; }
                    v2u o; o.x = pk2(yv[0], yv[1]); o.y = pk2(yv[2], yv[3]); *(GAS v2u*)(yrow + 16 * vi) = o; }
            }
        }
    };
    if constexpr (FULL) {
        gi[0] = 0.f; gf[0] = 0.f;
        MX_PREFETCH(0, 0);
        MX_STAGE_TILES(0, 0); MX_VECTORS(isR ? 0.f : gi[0], isR ? lgam : logsigf(gf[0]), 0);
        MX_PREFETCH(0, 1);
        MX_STAGE_TILES(0, 1); MX_VECTORS(isR ? 0.f : gi[0], isR ? lgam : logsigf(gf[0]), 1);
        __syncthreads();
        step1(std::integral_constant<int, 0>{});
        for (int c0 = 0; c0 < 16; c0 += 2) {
            body(std::integral_constant<int, 0>{}, std::false_type{}, c0);
            body(std::integral_constant<int, 1>{}, std::false_type{}, c0 + 1);
        }
    } else {
        if (grp == 0) body(std::integral_constant<int, 0>{}, std::true_type{}, -1);
#pragma unroll
        for (int u = 0; u < PD; ++u) { gi[u] = 0.f; gf[u] = 0.f; MX_PREFETCH(u, u); }
        for (int c0 = 0; c0 < 16; c0 += PD) {
            body(std::integral_constant<int, 0>{}, std::false_type{}, c0);
            body(std::integral_constant<int, 1 % PD>{}, std::false_type{}, c0 + 1);
            body(std::integral_constant<int, 2 % PD>{}, std::false_type{}, c0 + 2);
            body(std::integral_constant<int, 3 % PD>{}, std::false_type{}, c0 + 3);
        }
    }
#undef MX_PREFETCH
#undef MX_STAGE_TILES
#undef MX_VECTORS
#undef L_QT
#undef L_PTB
#undef L_KT
#undef L_VT
#undef L_VEC
#undef L_GS
    if (!FULL) {
#pragma unroll
        for (int nb = 0; nb < 9; ++nb) SL[(size_t)item * (STATE_BYTES / 16) + (w * 9 + nb) * 64 + lane] = accC[nb];
        if (tid == 0) GSUM[item] = gsum;
    }
    __syncthreads();
}

template <int CTRL> __device__ __forceinline__ unsigned dpp_u(unsigned v) { return (unsigned)__builtin_amdgcn_mov_dpp((int)v, CTRL, 0xf, 0xf, false); }
template <int MASK> __device__ __forceinline__ unsigned row_xor(unsigned v) {
    if constexpr (MASK == 1) return dpp_u<0xB1>(v);
    else if constexpr (MASK == 2) return dpp_u<0x4E>(v);
    else if constexpr (MASK == 3) return dpp_u<0x1B>(v);
    else if constexpr (MASK == 4) return dpp_u<0x1B>(dpp_u<0x141>(v));
    else if constexpr (MASK == 7) return dpp_u<0x141>(v);
    else if constexpr (MASK == 8) return dpp_u<0x128>(v);
    else { static_assert(MASK == 15, "row_xor mask"); return dpp_u<0x140>(v); }
}
__device__ __forceinline__ unsigned umax_(unsigned a, unsigned b) { return a > b ? a : b; }
__device__ __forceinline__ unsigned umin_(unsigned a, unsigned b) { return a < b ? a : b; }
template <int R, int X, bool FLIP> __device__ __forceinline__ void rs_stage(unsigned (&v)[R], int l16) {
    if constexpr (X < R) {
#pragma unroll
        for (int r = 0; r < R; ++r) { const int r2 = r ^ X; if (r < r2) { const unsigned a = v[r], b = v[r2]; v[r] = umax_(a, b); v[r2] = umin_(a, b); } }
    } else {
        constexpr int M = FLIP ? ((X + 1) / R - 1) : (X / R);
        constexpr int HB = FLIP ? ((X + 1) / (2 * R)) : (X / R);
        const bool lower = (l16 & HB) == 0;
        if constexpr (FLIP) {
#pragma unroll
            for (int r = 0; r < R / 2; ++r) { const int r2 = R - 1 - r; const unsigned pa = row_xor<M>(v[r2]), pb = row_xor<M>(v[r]);
                v[r] = lower ? umax_(v[r], pa) : umin_(v[r], pa); v[r2] = lower ? umax_(v[r2], pb) : umin_(v[r2], pb); }
        } else {
#pragma unroll
            for (int r = 0; r < R; ++r) { const unsigned p = row_xor<M>(v[r]); v[r] = lower ? umax_(v[r], p) : umin_(v[r], p); }
        }
    }
}
template <int R, int K, int J> __device__ __forceinline__ void rs_half(unsigned (&v)[R], int l16) { if constexpr (J >= 1) { rs_stage<R, J, false>(v, l16); rs_half<R, K, J / 2>(v, l16); } }
template <int R, int K> __device__ __forceinline__ void rs_sort(unsigned (&v)[R], int l16) {
    if constexpr (K > 2) rs_sort<R, K / 2>(v, l16);
    rs_stage<R, K - 1, true>(v, l16); rs_half<R, K, K / 4>(v, l16);
}
template <int MASK> __device__ __forceinline__ void rs_merge_top16(unsigned (&v)[32]) {
    unsigned p[16];
#pragma unroll
    for (int i = 0; i < 16; ++i) p[i] = row_xor<MASK>(v[15 - i]);
#pragma unroll
    for (int i = 0; i < 16; ++i) v[i] = umax_(v[i], p[i]);
#pragma unroll
    for (int J = 8; J >= 1; J >>= 1)
#pragma unroll
        for (int r = 0; r < 16; ++r) { const int r2 = r ^ J; if (r < r2) { const unsigned a = v[r], b = v[r2]; v[r] = umax_(a, b); v[r2] = umin_(a, b); } }
}
__device__ __forceinline__ void rs_top16_q4(unsigned (&v)[32]) { rs_sort<32, 32>(v, 0); rs_merge_top16<1>(v); rs_merge_top16<2>(v); }
__device__ __forceinline__ unsigned f2key(float f) { const unsigned u = __builtin_bit_cast(unsigned, f); return (u & 0x80000000u) ? ~u : (u | 0x80000000u); }
__device__ __forceinline__ float key2f(unsigned k) { return __builtin_bit_cast(float, (k & 0x80000000u) ? (k & 0x7fffffffu) : ~k); }

constexpr int PEER_TPB = M / 256;
constexpr int L_SLOT = 0, SLOT_BYTES = 1024;
constexpr int L_FLAG = 131072, L_TAB = L_FLAG + 1024, L_PW = L_TAB + 256, PW_BYTES = 1024;
constexpr int PEER_NR = 4;
constexpr int L_XW = L_PW + PEER_NR * PW_BYTES, XW_BYTES = 1536;
static_assert(L_XW + 8 * XW_BYTES <= LDSCTL_OFF, "PEER LDS layout");
#ifndef MK_NPB
#define MK_NPB 256
#endif
__device__ __forceinline__ void peer_item(const Args& A, const Ctx& C, const int item) {
    unsigned char* ws = A.ws; LAS unsigned char* lds = C.lds;
    const int tid = C.tid, lane = C.lane, wave = C.wave;
    LAS int* TAB = (LAS int*)(lds + L_TAB);
    volatile LAS int* FLAG = (volatile LAS int*)(lds + L_FLAG);
    if (tid < 64) { int code = -1, cbase = 0;
        for (int i = 0; i < 16; ++i) { const int n = 16 / (i + 1); if (code < 0 && tid < cbase + n) code = i * 16 + (tid - cbase); cbase += n; }
        TAB[tid] = code; }
    if (tid < PEER_TPB) FLAG[tid] = 0;
    if (tid == 0) FLAG[PEER_TPB] = 0;
    __syncthreads();
    const int tok_base = item * PEER_TPB;
    const _Float16* S = (const _Float16*)(ws + WS_PROJ); const float* SSQ = (const float*)(ws + WS_SSQ);
    if (wave < PEER_NR) {
        const int l4 = lane & 3, l8 = lane & 7;
        int tabc[8];
#pragma unroll
        for (int r = 0; r < 8; ++r) tabc[r] = TAB[l8 * 8 + r];
        LAS unsigned* SK = (LAS unsigned*)(lds + L_PW + wave * PW_BYTES);
        typedef _Float16 h8_t __attribute__((ext_vector_type(8)));
        h8_t nS[4]; float nss = 0.f;
#define PEER_PREFETCH_S(t_) do { const _Float16* sp_ = S + (size_t)(t_) * PEERN + 32 * lane; _Pragma("unroll") for (int i_ = 0; i_ < 4; ++i_) nS[i_] = *(const h8_t*)(sp_ + 8 * i_); \
            nss = SSQ[(size_t)(t_) * 64 + lane]; } while (0)
        PEER_PREFETCH_S(tok_base + wave);
#pragma unroll 1
        for (int ti = wave; ti < PEER_TPB; ti += PEER_NR) {
            const int tok = tok_base + ti;
            const float rstd2 = __builtin_amdgcn_rsqf(wave_sum(nss) * (1.f / D) + EPS);
            unsigned v[32];
#pragma unroll
            for (int i = 0; i < 4; ++i) { const h8_t s8 = nS[i];
#pragma unroll
                for (int k = 0; k < 8; ++k) { const float sf = (float)s8[k]; v[8 * i + k] = (f2key(sf) & ~127u) | (unsigned)(l4 * 32 + 8 * i + k); } }
            if (ti + PEER_NR < PEER_TPB) PEER_PREFETCH_S(tok + PEER_NR);
            LAS int* EI = (LAS int*)(lds + L_SLOT + ti * SLOT_BYTES); LAS float* GT = (LAS float*)(lds + L_SLOT + ti * SLOT_BYTES + 512);
            rs_top16_q4(v);
            if (l4 == 0) {
#pragma unroll
                for (int q = 0; q < 4; ++q) *(LAS v4u*)(SK + (lane >> 2) * 16 + 4 * q) = (v4u){v[4 * q], v[4 * q + 1], v[4 * q + 2], v[4 * q + 3]}; }
            __builtin_amdgcn_wave_barrier(); asm volatile("" ::: "memory");
            const int hd = lane >> 3;
            unsigned c[8];
#pragma unroll
            for (int r = 0; r < 8; ++r) { const int code = tabc[r]; unsigned key = 0u;
                if (code >= 0) { const float sum = key2f(SK[(2 * hd) * 16 + (code >> 4)] & ~127u) + key2f(SK[(2 * hd + 1) * 16 + (code & 15)] & ~127u); key = (f2key(sum) & ~255u) | (unsigned)code; }
                c[r] = key; }
            rs_sort<8, 64>(c, l8);
            const unsigned topk = (unsigned)__shfl((int)c[0], lane & ~7);
            const float mx = key2f(topk & ~255u) * rstd2;
            float ex[8]; float sm = 0.f;
#pragma unroll
            for (int r = 0; r < 8; ++r) { ex[r] = (l8 < 2) ? __expf(key2f(c[r] & ~255u) * rstd2 - mx) : 0.f; sm += ex[r]; }
            sm += dpp_f<0xB1>(sm);
            const float rsm = __builtin_amdgcn_rcpf(sm);
            if (l8 < 2) {
#pragma unroll
                for (int r = 0; r < 8; ++r) { const int code = (int)(c[r] & 255u);
                    const int n1 = (int)(SK[(2 * hd) * 16 + (code >> 4)] & 127u), n2 = (int)(SK[(2 * hd + 1) * 16 + (code & 15)] & 127u);
                    EI[hd * 16 + l8 * 8 + r] = (n1 * 128 + n2) * (D / 2); GT[hd * 16 + l8 * 8 + r] = ex[r] * rsm; }
            }
            __builtin_amdgcn_wave_barrier(); asm volatile("" ::: "memory");
            asm volatile("s_waitcnt lgkmcnt(0)" ::: "memory");
            if (lane == 0) FLAG[ti] = 1;
        }
#undef PEER_PREFETCH_S
    }
    {
        auto peer_claim = [&]() -> int { int c_ = 0; if (lane == 0) c_ = __hip_atomic_fetch_add((LAS int*)(lds + L_FLAG) + PEER_TPB, 1, __ATOMIC_RELAXED, __HIP_MEMORY_SCOPE_WORKGROUP); return __builtin_amdgcn_readfirstlane(c_); };
#define PEER_CLAIM() peer_claim()
        const unsigned char* UD = ws + WS_UD; const unsigned char* VU = ws + WS_VU;
        LAS unsigned char* X8 = lds + L_XW + wave * XW_BYTES; LAS float* TT = (LAS float*)(X8 + 1024);
        const bf16* H1B = (const bf16*)(ws + WS_H1B);
        v4u nX[2]; float nss = 0.f;
        typedef int i32x8 __attribute__((ext_vector_type(8))); typedef float f32x16 __attribute__((ext_vector_type(16)));
        unsigned amsk[4];
#pragma unroll
        for (int d = 0; d < 4; ++d) amsk[d] = ((((lane & 31) >> 4) == (lane >> 5)) && (((lane & 15) >> 2) == d)) ? (0xffu << (8 * (lane & 3))) : 0u;
        const int half = lane >> 5, l32 = lane & 31, cb = 2 * l32 + half;
#define PEER_PREFETCH_X(t_) do { const bf16* xp_ = H1B + (size_t)(t_) * D + 16 * cb; nX[0] = *(const v4u*)xp_; nX[1] = *(const v4u*)(xp_ + 8); nss = SSQ[(size_t)(t_) * 64 + lane]; } while (0)
        int ti = PEER_CLAIM(), ti_next = PEER_TPB;
        if (ti < PEER_TPB) PEER_PREFETCH_X(tok_base + ti);
#pragma unroll 1
        for (; ti < PEER_TPB; ti = ti_next) {
            const int tok = tok_base + ti;
            ti_next = PEER_CLAIM();
            const float rstd2 = __builtin_amdgcn_rsqf(wave_sum(nss) * (1.f / D) + EPS);
            float* orow = A.out + (size_t)tok * D + 16 * cb;
            float xr[16];
#pragma unroll
            for (int j = 0; j < 8; ++j) { const unsigned wj = nX[j >> 2][j & 3]; xr[2 * j] = bflo(wj); xr[2 * j + 1] = bfhi(wj); }
            if (ti_next < PEER_TPB) PEER_PREFETCH_X(tok_base + ti_next);
            {
                const float xs = rstd2 * XSCALE; v4u x8;
#pragma unroll
                for (int j = 0; j < 4; ++j) { int wx = 0; wx = __builtin_amdgcn_cvt_pk_fp8_f32(xr[4 * j] * xs, xr[4 * j + 1] * xs, wx, false); wx = __builtin_amdgcn_cvt_pk_fp8_f32(xr[4 * j + 2] * xs, xr[4 * j + 3] * xs, wx, true); x8[j] = (unsigned)wx; }
                *(LAS v4u*)(X8 + 16 * cb) = x8;
            }
            while (FLAG[ti] == 0) __builtin_amdgcn_s_sleep(8);
            asm volatile("" ::: "memory");
            const LAS int* EI = (const LAS int*)(lds + L_SLOT + ti * SLOT_BYTES); const LAS float* GT = (const LAS float*)(lds + L_SLOT + ti * SLOT_BYTES + 512);
            float ttv[2];
            {
                const int m16 = lane & 15, kg = lane >> 4;
                const unsigned char* ub[8];
                f32x4 au[8];
#pragma unroll
                for (int mt = 0; mt < 8; ++mt) au[mt] = (f32x4){0.f, 0.f, 0.f, 0.f};
#if PEER_PROBE_U
#pragma unroll 1
                for (int rep = 0; rep < 2; ++rep) {
                const int imask = rep ? A.imask : -1; const unsigned xmask = rep ? (unsigned)A.izero : 0xffffffffu;
#else
                { const int imask = -1; const unsigned xmask = 0xffffffffu;
#endif
#pragma unroll
                for (int mt = 0; mt < 8; ++mt) ub[mt] = UD + (unsigned)((EI[16 * mt + (lane >> 2)] & imask) + 16 * (lane & 3));
                const int paddr = (4 * m16 + kg) << 2;
                v4u ra[8], rb[8];
#define PU_LOAD(buf_, s_) do { _Pragma("unroll") for (int mt_ = 0; mt_ < 8; ++mt_) buf_[mt_] = *(const v4u*)(ub[mt_] + 64 * (s_)); } while (0)
#define PU_STEP(cur_, nxt_, s_) do { \
                    const v4u x0_ = *(const LAS v4u*)(X8 + 128 * (s_) + 16 * kg) & xmask, x1_ = *(const LAS v4u*)(X8 + 128 * (s_) + 64 + 16 * kg) & xmask; \
                    const i32x8 xb_ = {(int)x0_.x, (int)x0_.y, (int)x0_.z, (int)x0_.w, (int)x1_.x, (int)x1_.y, (int)x1_.z, (int)x1_.w}; \
                    _Pragma("unroll") for (int mt_ = 0; mt_ < 8; ++mt_) { const v4u a_ = cur_[mt_]; \
                        const i32x8 ab_ = {__builtin_amdgcn_ds_bpermute(paddr, (int)a_.x), __builtin_amdgcn_ds_bpermute(paddr, (int)a_.y), __builtin_amdgcn_ds_bpermute(paddr, (int)a_.z), __builtin_amdgcn_ds_bpermute(paddr, (int)a_.w), 0, 0, 0, 0}; \
                        au[mt_] = __builtin_amdgcn_mfma_scale_f32_16x16x128_f8f6f4(ab_, xb_, au[mt_], 4  , 0  , 0, 0x7f7f7f7f, 0, 0x7f7f7f7f); } } while (0)
                PU_LOAD(ra, 0); PU_LOAD(rb, 1);
#pragma unroll 1
                for (int t = 0; t < 6; t += 2) {
                    PU_STEP(ra, ra, t); PU_LOAD(ra, t + 2);
                    PU_STEP(rb, rb, t + 1); PU_LOAD(rb, t + 3); }
                PU_STEP(ra, ra, 6); PU_STEP(rb, rb, 7);
                }
#undef PU_STEP
#undef PU_LOAD
                if (m16 == 0) {
#pragma unroll
                    for (int mt = 0; mt < 8; ++mt) *(LAS f32x4*)(TT + 16 * mt + 4 * kg) = au[mt]; }
                __builtin_amdgcn_wave_barrier(); asm volatile("s_waitcnt lgkmcnt(0)" ::: "memory");
                ttv[0] = TT[lane]; ttv[1] = TT[lane + 64];
                __builtin_amdgcn_wave_barrier(); asm volatile("" ::: "memory");
            }
            v4u v8[16];
#pragma unroll
            for (int q = 0; q < 16; ++q) v8[q] = *(const v4u*)(VU + (unsigned)(EI[2 * q + half] + 16 * l32));
            constexpr float CFS = 64.f;
            unsigned cfp[2];
#pragma unroll
            for (int j = 0; j < 2; ++j) { const float tt = ttv[j] * (1.f / (USCALE * XSCALE)); float c = GT[lane + 64 * j] * (0.5f * CFS) * tt * (1.f + erff(tt * 0.70710678118654752f));
                c = fminf(fmaxf(c, -448.f), 448.f);
                cfp[j] = ((unsigned)__builtin_amdgcn_cvt_pk_fp8_f32(c, c, 0, false) & 0xffffu) * 0x00010001u; }
            LAS unsigned* CFL = (LAS unsigned*)TT;
            CFL[lane] = cfp[0]; CFL[lane + 64] = cfp[1];
            asm volatile("" ::: "memory");
            f32x16 accv, accw;
#pragma unroll
            for (int i = 0; i < 16; ++i) { accv[i] = 0.f; accw[i] = 0.f; }
#define PV_ROW(q_, e0_) do { const unsigned c0_ = CFL[(e0_) + 2 * (q_)], c1_ = CFL[(e0_) + 2 * (q_) + 1]; \
                    const i32x8 a_ = {(int)(c0_ & amsk[0]), (int)(c0_ & amsk[1]), (int)(c0_ & amsk[2]), (int)(c0_ & amsk[3]), (int)(c1_ & amsk[0]), (int)(c1_ & amsk[1]), (int)(c1_ & amsk[2]), (int)(c1_ & amsk[3])}; \
                    const i32x8 b_ = {(int)v8[q_].x, (int)v8[q_].y, (int)v8[q_].z, (int)v8[q_].w, 0, 0, 0, 0}; \
                    if ((q_) & 1) accw = __builtin_amdgcn_mfma_scale_f32_32x32x64_f8f6f4(a_, b_, accw, 0  , 4  , 0, 0x7f7f7f7f, 0, 0x7f7f7f7f); \
                    else accv = __builtin_amdgcn_mfma_scale_f32_32x32x64_f8f6f4(a_, b_, accv, 0  , 4  , 0, 0x7f7f7f7f, 0, 0x7f7f7f7f); } while (0)
#pragma unroll 1
            for (int e0 = 0; e0 < 96; e0 += 32) {
#pragma unroll
                for (int q = 0; q < 16; ++q) { PV_ROW(q, e0); v8[q] = *(const v4u*)(VU + (unsigned)(EI[e0 + 32 + 2 * q + half] + 16 * l32)); }
            }
#pragma unroll
            for (int q = 0; q < 16; ++q) PV_ROW(q, 96);
#undef PV_ROW
            float acc[16];
#pragma unroll
            for (int i = 0; i < 16; ++i) acc[i] = (accv[i] + accw[i]) * (1.f / (CFS * VSCALE));
            float q2 = 0.f;
#pragma unroll
            for (int j = 0; j < 16; ++j) { xr[j] += acc[j]; q2 += xr[j] * xr[j]; }
            q2 = wave_sum(q2);
            const float rf = __builtin_amdgcn_rsqf(q2 * (1.f / D) + EPS);
#pragma unroll
            for (int j = 0; j < 4; ++j) { const f32x4 fw = *(const f32x4*)(A.final_w + 16 * cb + 4 * j);
                *(f32x4*)(orow + 4 * j) = (f32x4){xr[4 * j] * rf * fw.x, xr[4 * j + 1] * rf * fw.y, xr[4 * j + 2] * rf * fw.z, xr[4 * j + 3] * rf * fw.w}; }
        }
#undef PEER_PREFETCH_X
#undef PEER_CLAIM
    }
}

__device__ __forceinline__ void peer_tokens(const Args& A, const Ctx& C) {
    if (C.vcu >= MK_NPB) return;
    for (int item = C.vcu; item < M / PEER_TPB; item += MK_NPB) { peer_item(A, C, item); __syncthreads(); }
}

template <int LO, int HI> __global__ void __launch_bounds__(NWAVES * 64, 2) mk_fwd(Args args) {
    extern __shared__ __attribute__((aligned(16))) unsigned char lds_raw[];
    Ctx C;
    C.lds = (LAS unsigned char*)lds_raw;
    C.tid = threadIdx.x; C.lane = C.tid & 63; C.wave = __builtin_amdgcn_readfirstlane(C.tid >> 6);
    C.G = gridDim.x; { const int bx = blockIdx.x; C.vcu = (C.G % 8 == 0) ? (bx % 8) * (C.G / 8) + bx / 8 : bx; }
    volatile LAS unsigned* MISC = (volatile LAS unsigned*)(C.lds + MISC_OFF);
    gu32* ctl = (gu32*)(args.ws + WS_CTL);
    for (int u = C.tid; u < (LDS_BYTES - LDSCTL_OFF) / 4; u += NWAVES * 64) ((LAS unsigned*)(C.lds + LDSCTL_OFF))[u] = 0u;
    __syncthreads();
    XcdBarrier bar; bar.bar = (unsigned*)(ctl + CW_BAR); bar.x = 0; bar.st = nullptr;
    if (HI - LO > 1) bar = xcd_barrier_post((unsigned*)(ctl + CW_BAR), MISC + 8);
#define GRID_BAR() do { if (HI - LO > 1) xcd_barrier(bar); } while (0)
    constexpr int lo = LO, hi = HI;
#define IN(k) (lo <= (k) && (k) < hi)
#define BOTH(k) (IN(k) && IN((k) + 1))
    unsigned char* ws = args.ws;
    for (int rp = 0; rp < ((DUP & 1) ? 2 : 1); ++rp) if (IN(0)) { const Ctx Cp = fresh_ctx(C); p0_prep(args, Cp); if (BOTH(0)) GRID_BAR(); }
    for (int rp = 0; rp < ((DUP & 2) ? 2 : 1); ++rp) if (IN(1)) {
        pg8::Gemm g{(const pg8::bf16_t*)(ws + WS_XN), (const pg8::bf16_t*)(ws + WS_WIN), M, NPROJ, D}; pg8::StaticOrder S; S.init(M, NPROJ, C.G, (int)blockIdx.x);
        pg8::EpiProj E{(pg8::bf16_t*)(ws + WS_PROJ), (const float*)(ws + WS_ROT)};
        pg8::gemm_phase<pg8::EpiProj, pg8::StaticOrder, PG8_ALIGN, PG8_SP2>(C.lds + RING_OFF, g, S, E);
        if (BOTH(1)) GRID_BAR();
    }
    for (int rp = 0; rp < ((DUP & 4) ? 2 : 1); ++rp) if (IN(2)) { const Ctx Cp = fresh_ctx(C); for (int it = C.vcu; it < 256; it += C.G) mixer_item<false>(args, Cp, it); if (BOTH(2)) GRID_BAR(); }
    for (int rp = 0; rp < ((DUP & 8) ? 2 : 1); ++rp) if (IN(3)) { const Ctx Cp = fresh_ctx(C); for (int it = C.vcu; it < 256; it += C.G) mixer_item<true>(args, Cp, it); if (BOTH(3)) GRID_BAR(); }
    for (int rp = 0; rp < ((DUP & 16) ? 2 : 1); ++rp) if (IN(4)) {
        pg8::Gemm g{(const pg8::bf16_t*)(ws + WS_XN), (const pg8::bf16_t*)(ws + WS_WOUT), M, D, D}; pg8::StaticOrder S; S.init(M, D, C.G, (int)blockIdx.x);
        pg8::EpiOut E{args.x, (pg8::bf16_t*)(ws + WS_H1B), (float*)(ws + WS_SSQ)};
        pg8::gemm_phase<pg8::EpiOut, pg8::StaticOrder, PG8_ALIGN, PG8_SP2>(C.lds + RING_OFF, g, S, E);
        if (BOTH(4)) GRID_BAR();
    }
    for (int rp = 0; rp < ((DUP & 32) ? 2 : 1); ++rp) if (IN(5)) {
        pg8::Gemm g{(const pg8::bf16_t*)(ws + WS_H1B), (const pg8::bf16_t*)(ws + WS_WPEER), M, PEERN, D}; pg8::StaticOrder S; S.init(M, PEERN, C.G, (int)blockIdx.x);
        pg8::EpiF16 E{(unsigned short*)(ws + WS_PROJ), PEERN};
        pg8::gemm_phase<pg8::EpiF16, pg8::StaticOrder, PG8_ALIGN, PG8_SP2>(C.lds + RING_OFF, g, S, E);
        if (BOTH(5)) GRID_BAR();
    }
    if (IN(6)) { const Ctx Cp = fresh_ctx(C); peer_tokens(args, Cp); }
#undef IN
#undef BOTH
}

typedef void (*kern_t)(Args);
static kern_t kern_for(int li) {
    if constexpr (N_LAUNCHES == 1) return mk_fwd<0, N_PHASES>;
    else switch (li) { case 0: return mk_fwd<0, 1>; case 1: return mk_fwd<1, 2>; case 2: return mk_fwd<2, 3>; case 3: return mk_fwd<3, 4>; case 4: return mk_fwd<4, 5>; case 5: return mk_fwd<5, 6>; default: return mk_fwd<6, 7>; }
}
extern "C" void kernel_launch(void* const* d_in, const int* in_sizes, int n_in, void* d_out, int out_size, void* d_ws, size_t ws_size, hipStream_t stream) {
    static int grid = 0;
    if (grid == 0) {
        if (n_in != 14 || in_sizes[0] != M * D || out_size != M * D || ws_size < WS_END) { fprintf(stderr, "kernel_launch: unexpected shapes (n_in %d, in0 %d, out %d, ws %zu < %zu); nothing launched\n", n_in, n_in > 0 ? in_sizes[0] : -1, out_size, ws_size, (size_t)WS_END); grid = -1; return; }
        int dev = 0, cus = 0;
        if (hipGetDevice(&dev) != hipSuccess || hipDeviceGetAttribute(&cus, hipDeviceAttributeMultiprocessorCount, dev) != hipSuccess) { grid = -1; return; }
        for (int li = 0; li < N_LAUNCHES; ++li) {
            int per_cu = 0;
            if (hipFuncSetAttribute((const void*)kern_for(li), hipFuncAttributeMaxDynamicSharedMemorySize, LDS_BYTES) != hipSuccess) { fprintf(stderr, "kernel_launch: hipFuncSetAttribute failed\n"); grid = -1; return; }
            if (hipOccupancyMaxActiveBlocksPerMultiprocessor(&per_cu, (const void*)kern_for(li), NWAVES * 64, LDS_BYTES) != hipSuccess || per_cu < 1) { fprintf(stderr, "kernel_launch: occupancy query says %d blocks per CU for launch %d\n", per_cu, li); (void)hipGetLastError(); grid = -1; return; }
        }
        (void)hipGetLastError();
        grid = cus;
    }
    if (grid < 0) return;
    if (hipMemsetAsync((char*)d_ws + WS_CTL, 0, CTL_ZERO_BYTES, stream) != hipSuccess) { fprintf(stderr, "kernel_launch: memset failed\n"); return; }
    Args a{};
    a.x = (const float*)d_in[0]; a.meta = (const float*)d_in[1]; a.norm1_w = (const float*)d_in[2]; a.w_in = (const float*)d_in[3]; a.gate_bias = (const float*)d_in[4];
    a.m_norm_w = (const float*)d_in[5]; a.r_norm_w = (const float*)d_in[6]; a.w_out = (const float*)d_in[7]; a.norm2_w = (const float*)d_in[8]; a.w_query = (const float*)d_in[9];
    a.sub_keys = (const float*)d_in[10]; a.w_down = (const float*)d_in[11]; a.w_up = (const float*)d_in[12]; a.final_w = (const float*)d_in[13];
    a.out = (float*)d_out; a.ws = (unsigned char*)d_ws; a.fzero = 0.f; a.imask = PEER_PROBE_MASK; a.izero = 0;
    for (int li = 0; li < N_LAUNCHES; ++li) {
        hipLaunchKernelGGL(kern_for(li), dim3(grid), dim3(NWAVES * 64), LDS_BYTES, stream, a);
        const hipError_t le = hipPeekAtLastError();
        if (le != hipSuccess) { fprintf(stderr, "kernel_launch: launch %d failed: %s\n", li, hipGetErrorName(le)); break; }
    }
}
```

```cpp
#include <hip/hip_runtime.h>
#include <cstdio>
#include <cstdint>
#include <type_traits>
namespace pg8 {
#define PG8_LAS __attribute__((address_space(3)))
typedef unsigned short bf16_t;
typedef short bf16x8 __attribute__((ext_vector_type(8)));
typedef float f32x4 __attribute__((ext_vector_type(4)));
typedef unsigned u32x4 __attribute__((ext_vector_type(4)));
typedef int i32x4_t __attribute__((ext_vector_type(4)));
constexpr int BM = 256, BK = 64, HALF = 128, HTB = HALF * BK * 2  , STAGE_BYTES = 8 * HTB, NXCD = 8, WGM = 8;

__host__ __device__ __forceinline__ int lds_byte(int r, int c) { const int st = (r >> 4) * 2 + (c >> 5), rr = r & 15, cc = c & 31, ob = rr * 64 + cc * 2; return st * 1024 + (ob ^ (((ob >> 9) & 1) << 5)); }
__host__ __device__ __forceinline__ void stage_rc(int b, int& R, int& C) { const int st = b / 1024, sb = b % 1024, swz = sb ^ (((sb >> 9) & 1) << 5); R = (st >> 1) * 16 + swz / 64; C = (st & 1) * 32 + (swz % 64) / 2; }
__host__ __device__ __forceinline__ int perm32(int rho) { const int n = rho >> 4, i = rho & 15; return 8 * (i >> 2) + 4 * n + (i & 3); }

struct Unit { int pm, pn; };
struct Gemm { const bf16_t* A; const bf16_t* Bt; int M, N, K; };

struct StaticOrder {
    int nM, nN, nwg, G, c;
    __host__ __device__ void init(int M, int N, int G_, int c_) { nM = M / BM; nN = N / BM; nwg = nM * nN; G = G_; c = c_; }
    __host__ __device__ bool next(int i, Unit& u) const {
        const long L = (long)i * G + c; if (L >= nwg) return false;
        int wgid = (int)L; { const int q = nwg / NXCD, r = nwg % NXCD, xcd = wgid % NXCD, off = wgid / NXCD; wgid = (xcd < r ? xcd * (q + 1) : r * (q + 1) + (xcd - r) * q) + off; }
        const int nig = WGM * nN, gid = wgid / nig, fm = gid * WGM, gsz = (nM - fm) < WGM ? (nM - fm) : WGM;
        u.pm = fm + ((wgid % nig) % gsz); u.pn = (wgid % nig) / gsz; return true;
    }
    __device__ __forceinline__ void a_ready(const Unit&) const {}
    __device__ __forceinline__ void done(const Unit&) const {}
};
__device__ __forceinline__ unsigned cvt_pk_bf16(float lo, float hi) { unsigned r; asm volatile("v_cvt_pk_bf16_f32 %0, %1, %2" : "=v"(r) : "v"(lo), "v"(hi)); return r; }
typedef unsigned u32x2 __attribute__((ext_vector_type(2)));

struct EpiProj {
    static constexpr bool PERM = true, AFTER_DRAIN = false;
    bf16_t* O; const float* rot;
    __device__ __forceinline__ void operator()(const f32x4 (&acc)[2][2][4][2], const Unit& u, int wr, int wc, int fr, int fq) const {
        const int row0 = u.pm * BM + wr * 64 + fr, col0 = u.pn * BM + wc * 32 + 8 * fq;
        const bool rotary = (u.pn >= 8 && u.pn < 12);
        const int i4 = 4 * (4 * wc + fq);
#pragma unroll
        for (int ai = 0; ai < 2; ++ai)
#pragma unroll
            for (int m = 0; m < 4; ++m) {
                const int row = row0 + ai * HALF + m * 16;
                bf16_t* rowp = O + (size_t)row * 4096 + col0;
                f32x4 cv = (f32x4){1.f, 1.f, 1.f, 1.f}, sv = (f32x4){0.f, 0.f, 0.f, 0.f};
                if (rotary) { const int pos = (row & 8191) + 16; cv = *(const f32x4*)(rot + (size_t)pos * 128 + i4); sv = *(const f32x4*)(rot + (size_t)pos * 128 + 64 + i4); }
#pragma unroll
                for (int bj = 0; bj < 2; ++bj) {
                    const f32x4 x1 = acc[ai][bj][m][0], x2 = acc[ai][bj][m][1];
                    const f32x4 v0 = x1 * cv - x2 * sv, v1 = x1 * sv + x2 * cv;
                    u32x4 w; w.x = cvt_pk_bf16(v0[0], v0[1]); w.y = cvt_pk_bf16(v0[2], v0[3]); w.z = cvt_pk_bf16(v1[0], v1[1]); w.w = cvt_pk_bf16(v1[2], v1[3]);
                    *(u32x4*)(rowp + bj * HALF) = w; }
            }
    }
};
__device__ __forceinline__ unsigned pk4_fp8x16(const f32x4 h) { int w = 0; w = __builtin_amdgcn_cvt_pk_fp8_f32(__builtin_amdgcn_fmed3f(h[0] * 16.f, -448.f, 448.f), __builtin_amdgcn_fmed3f(h[1] * 16.f, -448.f, 448.f), w, false);
    w = __builtin_amdgcn_cvt_pk_fp8_f32(__builtin_amdgcn_fmed3f(h[2] * 16.f, -448.f, 448.f), __builtin_amdgcn_fmed3f(h[3] * 16.f, -448.f, 448.f), w, true); return (unsigned)w; }
struct EpiOut {
    static constexpr bool PERM = true, AFTER_DRAIN = false;
    const bf16_t* XN; const float* SIG; bf16_t* H1B; float* SSQ; unsigned char* H1Q;
    __device__ __forceinline__ void operator()(const f32x4 (&acc)[2][2][4][2], const Unit& u, int wr, int wc, int fr, int fq) const {
        const int row0 = u.pm * BM + wr * 64 + fr, col0 = u.pn * BM + wc * 32 + 8 * fq;
        u32x4 xb[2][2]; float sgb[2];
#define EPO_ROW(it_) (row0 + ((it_) >> 2) * HALF + ((it_) & 3) * 16)
#define EPO_LOAD(it_) do { const bf16_t* xp_ = XN + (size_t)EPO_ROW(it_) * 1024 + col0; xb[(it_) & 1][0] = *(const u32x4*)(xp_); xb[(it_) & 1][1] = *(const u32x4*)(xp_ + HALF); sgb[(it_) & 1] = SIG[EPO_ROW(it_)]; } while (0)
        EPO_LOAD(0);
#pragma unroll
        for (int it = 0; it < 8; ++it) {
                const int ai = it >> 2, m = it & 3;
                const int row = EPO_ROW(it); const size_t off = (size_t)row * 1024 + col0;
                if (it + 1 < 8) EPO_LOAD(it + 1);
                float ss = 0.f; unsigned q8[2][2]; const float sg = sgb[it & 1];
#pragma unroll
                for (int bj = 0; bj < 2; ++bj) {
                    const u32x4 xq = xb[it & 1][bj];
                    const f32x4 x0 = (f32x4){__builtin_bit_cast(float, xq.x << 16), __builtin_bit_cast(float, xq.x & 0xffff0000u), __builtin_bit_cast(float, xq.y << 16), __builtin_bit_cast(float, xq.y & 0xffff0000u)} * sg;
                    const f32x4 x1 = (f32x4){__builtin_bit_cast(float, xq.z << 16), __builtin_bit_cast(float, xq.z & 0xffff0000u), __builtin_bit_cast(float, xq.w << 16), __builtin_bit_cast(float, xq.w & 0xffff0000u)} * sg;
                    const f32x4 h0 = x0 + acc[ai][bj][m][0], h1 = x1 + acc[ai][bj][m][1];
                    u32x4 w; w.x = cvt_pk_bf16(h0[0], h0[1]); w.y = cvt_pk_bf16(h0[2], h0[3]); w.z = cvt_pk_bf16(h1[0], h1[1]); w.w = cvt_pk_bf16(h1[2], h1[3]);
                    *(u32x4*)(H1B + off + bj * HALF) = w;
                    q8[bj][0] = pk4_fp8x16(h0); q8[bj][1] = pk4_fp8x16(h1);
                    ss += ((h0[0] * h0[0] + h0[1] * h0[1]) + (h0[2] * h0[2] + h0[3] * h0[3])) + ((h1[0] * h1[0] + h1[1] * h1[1]) + (h1[2] * h1[2] + h1[3] * h1[3])); }
                {
                    const auto s0 = __builtin_amdgcn_permlane16_swap(q8[0][0], q8[1][0], false, false), s1 = __builtin_amdgcn_permlane16_swap(q8[0][1], q8[1][1], false, false);
                    const int odd = fq & 1;
                    u32x4 w; w.x = s0[0]; w.y = s1[0]; w.z = s0[1]; w.w = s1[1];
                    *(u32x4*)(H1Q + off - 8 * odd + odd * HALF) = w; }
                SSQ[(size_t)row * 64 + u.pn * 16 + wc * 4 + fq] = ss;
                asm volatile("" ::: "memory"); }
#undef EPO_LOAD
#undef EPO_ROW
    }
};
struct EpiF32 {
    static constexpr bool PERM = false, AFTER_DRAIN = false;
    float* C; int ldc;
    __device__ __forceinline__ void operator()(const f32x4 (&acc)[2][2][4][2], const Unit& u, int wr, int wc, int fr, int fq) const {
        const int row0 = u.pm * BM + wr * 64 + fr, col0 = u.pn * BM + wc * 32 + 4 * fq;
#pragma unroll
        for (int ai = 0; ai < 2; ++ai)
#pragma unroll
            for (int m = 0; m < 4; ++m) { float* rowp = C + (size_t)(row0 + ai * HALF + m * 16) * ldc + col0;
#pragma unroll
                for (int bj = 0; bj < 2; ++bj)
#pragma unroll
                    for (int n = 0; n < 2; ++n) *(f32x4*)(rowp + bj * HALF + n * 16) = acc[ai][bj][m][n]; }
    }
};

struct EpiF16 {
    static constexpr bool PERM = true, AFTER_DRAIN = false;
    unsigned short* C; int ldc;
    __device__ __forceinline__ void operator()(const f32x4 (&acc)[2][2][4][2], const Unit& u, int wr, int wc, int fr, int fq) const {
        typedef _Float16 h2_t __attribute__((ext_vector_type(2)));
        const int row0 = u.pm * BM + wr * 64 + fr, col0 = u.pn * BM + wc * 32 + 8 * fq;
#pragma unroll
        for (int ai = 0; ai < 2; ++ai)
#pragma unroll
            for (int m = 0; m < 4; ++m) { unsigned short* rowp = C + (size_t)(row0 + ai * HALF + m * 16) * ldc + col0;
#pragma unroll
                for (int bj = 0; bj < 2; ++bj) { const f32x4 v0 = acc[ai][bj][m][0], v1 = acc[ai][bj][m][1];
                    u32x4 w; w.x = __builtin_bit_cast(unsigned, __builtin_amdgcn_cvt_pkrtz(v0[0], v0[1])); w.y = __builtin_bit_cast(unsigned, __builtin_amdgcn_cvt_pkrtz(v0[2], v0[3]));
                    w.z = __builtin_bit_cast(unsigned, __builtin_amdgcn_cvt_pkrtz(v1[0], v1[1])); w.w = __builtin_bit_cast(unsigned, __builtin_amdgcn_cvt_pkrtz(v1[2], v1[3]));
                    *(u32x4*)(rowp + bj * HALF) = w; } }
    }
};
template <class Epi, class Sched, bool ALIGN_EPI = false, bool SP2 = false, bool F8 = false>
__device__ __forceinline__ void gemm_phase(PG8_LAS unsigned char* lds, const Gemm g, const Sched& S, const Epi& E) {
    int tid_ = threadIdx.x; asm volatile("" : "+v"(tid_));
    const int tid = tid_, wid = __builtin_amdgcn_readfirstlane(tid >> 6), lane = tid & 63, wr = wid >> 2, wc = wid & 3, fr = lane & 15, fq = lane >> 4;
    const int K = g.K, nt = K / BK;
    unsigned voffA[2], voffB[2];
#pragma unroll
    for (int i = 0; i < 2; ++i) { int R, C; stage_rc(tid * 16 + i * 8192, R, C); const int Rb = Epi::PERM ? ((R & ~31) + perm32(R & 31)) : R;
        voffA[i] = (unsigned)(R * K + C) * 2u; voffB[i] = (unsigned)(Rb * K + C) * 2u; }
    const size_t kstep = (size_t)(BK * 2);
    const size_t hstep = (size_t)HALF * K * 2;
    const size_t tstep = 2 * hstep;
    const unsigned ldsw = (unsigned)wid * 1024u;
    const int aoff = lds_byte(wr * 64 + fr, fq * 8), boff = lds_byte(wc * 32 + fr, fq * 8);
#define PG8_SA(b, h) (((b) * 2 + (h)) * HTB)
#define PG8_SB(b, h) ((4 + (b) * 2 + (h)) * HTB)
#define PG8_STAGE(bufoff, gbase, voff) do { _Pragma("unroll") for (int _i = 0; _i < 2; ++_i) \
        __builtin_amdgcn_global_load_lds((const unsigned*)((const char*)(gbase) + (voff)[_i]), (PG8_LAS unsigned*)(lds + (bufoff) + ldsw + _i * 8192), 16, 0, 0); } while (0)
#define PG8_LDA(dst, b, h) do { _Pragma("unroll") for (int m = 0; m < 4; ++m) _Pragma("unroll") for (int k = 0; k < 2; ++k) dst[m][k] = *(const PG8_LAS bf16x8*)(lds + PG8_SA(b, h) + aoff + m * 2048 + k * 1024); } while (0)
#define PG8_LDB(dst, b, h) do { _Pragma("unroll") for (int n = 0; n < 2; ++n) _Pragma("unroll") for (int k = 0; k < 2; ++k) dst[n][k] = *(const PG8_LAS bf16x8*)(lds + PG8_SB(b, h) + boff + n * 2048 + k * 1024); } while (0)
#define PG8_CAT(x) __builtin_shufflevector(__builtin_bit_cast(i32x4_t, (x)[0]), __builtin_bit_cast(i32x4_t, (x)[1]), 0, 1, 2, 3, 4, 5, 6, 7)
#define PG8_MMA(ai, bj, At, Bt) do { __builtin_amdgcn_s_setprio(1); _Pragma("unroll") for (int m = 0; m < 4; ++m) _Pragma("unroll") for (int n = 0; n < 2; ++n) { \
        if constexpr (F8) asm volatile("v_mfma_scale_f32_16x16x128_f8f6f4 %0, %1, %2, %0, %3, %4 op_sel_hi:[0,0,0]" : "+v"(acc[ai][bj][m][n]) : "v"(PG8_CAT(Bt[n])), "v"(PG8_CAT(At[m])), "v"(f8sa), "v"(f8sb)); \
        else { _Pragma("unroll") for (int k = 0; k < 2; ++k) acc[ai][bj][m][n] = __builtin_amdgcn_mfma_f32_16x16x32_bf16(Bt[n][k], At[m][k], acc[ai][bj][m][n], 0, 0, 0); } } \
        __builtin_amdgcn_s_setprio(0); } while (0)
#define PG8_WAIT_V(n) asm volatile("s_waitcnt vmcnt(" #n ")" ::: "memory")
#define PG8_WAIT_L(n) asm volatile("s_waitcnt lgkmcnt(" #n ")" ::: "memory")
#define PG8_BAR __builtin_amdgcn_s_barrier()
#define PG8_SCHED __builtin_amdgcn_sched_barrier(0)
    Unit cur, nxt; int ui = 0;
    const int f8sa = 0x7b7b7b7b, f8sb = 0x77777777;
    if (!S.next(0, cur)) return;
    f32x4 acc[2][2][4][2];
#pragma unroll
    for (int a = 0; a < 2; ++a)
#pragma unroll
        for (int b = 0; b < 2; ++b)
#pragma unroll
            for (int m = 0; m < 4; ++m)
#pragma unroll
                for (int n = 0; n < 2; ++n) acc[a][b][m][n] = (f32x4){0.f, 0.f, 0.f, 0.f};
    bf16x8 At[4][2], B0[2][2], B1[2][2];
    const char* cA = (const char*)g.A + (size_t)cur.pm * tstep; const char* cB = (const char*)g.Bt + (size_t)cur.pn * tstep;
    S.a_ready(cur);
    if constexpr (SP2) {
        PG8_STAGE(PG8_SB(0, 0), cB, voffB); PG8_STAGE(PG8_SB(0, 1), cB + hstep, voffB); PG8_STAGE(PG8_SA(0, 0), cA, voffA); PG8_STAGE(PG8_SA(0, 1), cA + hstep, voffA);
        if (wr == 1) PG8_BAR;
        PG8_WAIT_V(2); PG8_BAR;
        PG8_STAGE(PG8_SB(1, 0), cB + kstep, voffB); PG8_STAGE(PG8_SA(1, 0), cA + kstep, voffA); PG8_STAGE(PG8_SB(1, 1), cB + hstep + kstep, voffB);
        PG8_WAIT_V(6); PG8_BAR;
    } else {
        PG8_STAGE(PG8_SB(0, 0), cB, voffB); PG8_STAGE(PG8_SA(0, 0), cA, voffA); PG8_STAGE(PG8_SB(0, 1), cB + hstep, voffB); PG8_STAGE(PG8_SA(0, 1), cA + hstep, voffA);
        if (wr == 1) PG8_BAR;
        PG8_WAIT_V(4); PG8_BAR;
        PG8_STAGE(PG8_SB(1, 0), cB + kstep, voffB); PG8_STAGE(PG8_SA(1, 0), cA + kstep, voffA); PG8_STAGE(PG8_SB(1, 1), cB + hstep + kstep, voffB);
        PG8_WAIT_V(6); PG8_BAR;
    }
    for (;;) {
        const bool has_next = S.next(ui + 1, nxt);
        const char* nA = has_next ? (const char*)g.A + (size_t)nxt.pm * tstep : cA; const char* nB = has_next ? (const char*)g.Bt + (size_t)nxt.pn * tstep : cB;
#pragma unroll 1
        for (int t = 0; t < nt; t += 2) {
            const bool last = (t == nt - 2);
            const char* a1 = cA + (size_t)(t + 1) * kstep;
            const char* a2 = last ? nA : cA + (size_t)(t + 2) * kstep; const char* b2 = last ? nB : cB + (size_t)(t + 2) * kstep;
            const char* a3 = a2 + kstep; const char* b3 = b2 + kstep;
            if (last && has_next) S.a_ready(nxt);
            if constexpr (SP2) {
            PG8_LDB(B0, 0, 0); PG8_LDB(B1, 0, 1); PG8_SCHED; PG8_LDA(At, 0, 0); PG8_STAGE(PG8_SA(1, 1), a1 + hstep, voffA);
            PG8_WAIT_V(8); PG8_WAIT_L(0); PG8_BAR; PG8_MMA(0, 0, At, B0); PG8_MMA(0, 1, At, B1); PG8_BAR; PG8_SCHED;
            PG8_LDA(At, 0, 1); PG8_STAGE(PG8_SB(0, 0), b2, voffB); PG8_STAGE(PG8_SB(0, 1), b2 + hstep, voffB); PG8_STAGE(PG8_SA(0, 0), a2, voffA);
            PG8_WAIT_V(8); PG8_WAIT_L(0); PG8_BAR; PG8_MMA(1, 0, At, B0); PG8_MMA(1, 1, At, B1); PG8_BAR; PG8_SCHED;
            PG8_LDB(B0, 1, 0); PG8_LDB(B1, 1, 1); PG8_SCHED; PG8_LDA(At, 1, 0); PG8_STAGE(PG8_SA(0, 1), a2 + hstep, voffA);
            PG8_WAIT_V(8); PG8_WAIT_L(0); PG8_BAR; PG8_MMA(0, 0, At, B0); PG8_MMA(0, 1, At, B1); PG8_BAR; PG8_SCHED;
            PG8_LDA(At, 1, 1); PG8_STAGE(PG8_SB(1, 0), b3, voffB); PG8_STAGE(PG8_SB(1, 1), b3 + hstep, voffB); PG8_STAGE(PG8_SA(1, 0), a3, voffA);
            PG8_WAIT_V(8); PG8_WAIT_L(0); PG8_BAR; PG8_MMA(1, 0, At, B0); PG8_MMA(1, 1, At, B1); PG8_BAR; PG8_SCHED;
            } else {
            PG8_LDB(B0, 0, 0); PG8_SCHED; PG8_LDA(At, 0, 0); PG8_STAGE(PG8_SA(1, 1), a1 + hstep, voffA);
            PG8_WAIT_L(8); PG8_BAR; PG8_WAIT_L(0); PG8_MMA(0, 0, At, B0); PG8_BAR; PG8_SCHED;
            PG8_LDB(B1, 0, 1); PG8_STAGE(PG8_SB(0, 0), b2, voffB);
            PG8_BAR; PG8_WAIT_L(0); PG8_MMA(0, 1, At, B1); PG8_BAR;
            PG8_LDA(At, 0, 1); PG8_STAGE(PG8_SA(0, 0), a2, voffA);
            PG8_BAR; PG8_WAIT_L(0); PG8_MMA(1, 0, At, B0); PG8_BAR; PG8_SCHED;
            PG8_STAGE(PG8_SB(0, 1), b2 + hstep, voffB);
            PG8_WAIT_V(6); PG8_BAR; PG8_MMA(1, 1, At, B1); PG8_BAR;
            PG8_LDB(B0, 1, 0); PG8_SCHED; PG8_LDA(At, 1, 0); PG8_STAGE(PG8_SA(0, 1), a2 + hstep, voffA);
            PG8_WAIT_L(8); PG8_BAR; PG8_WAIT_L(0); PG8_MMA(0, 0, At, B0); PG8_BAR; PG8_SCHED;
            PG8_LDB(B1, 1, 1); PG8_STAGE(PG8_SB(1, 0), b3, voffB);
            PG8_BAR; PG8_WAIT_L(0); PG8_MMA(0, 1, At, B1); PG8_BAR;
            PG8_LDA(At, 1, 1); PG8_STAGE(PG8_SA(1, 0), a3, voffA);
            PG8_BAR; PG8_WAIT_L(0); PG8_MMA(1, 0, At, B0); PG8_BAR; PG8_SCHED;
            PG8_STAGE(PG8_SB(1, 1), b3 + hstep, voffB);
            PG8_WAIT_V(6); PG8_BAR; PG8_MMA(1, 1, At, B1); PG8_BAR;
            }
        }
        if constexpr (F8) asm volatile("s_nop 15\n\ts_nop 15" ::: "memory");
        if constexpr (ALIGN_EPI) { if (wr == 0) PG8_BAR; }
        if constexpr (!Epi::AFTER_DRAIN) { E(acc, cur, wr, wc, fr, fq); S.done(cur); }
        if (!has_next) break;
#pragma unroll
        for (int a = 0; a < 2; ++a)
#pragma unroll
            for (int b = 0; b < 2; ++b)
#pragma unroll
                for (int m = 0; m < 4; ++m)
#pragma unroll
                    for (int n = 0; n < 2; ++n) acc[a][b][m][n] = (f32x4){0.f, 0.f, 0.f, 0.f};
        cur = nxt; cA = nA; cB = nB; ++ui;
        if constexpr (ALIGN_EPI) { if (wr == 1) PG8_BAR; }
    }
    PG8_WAIT_V(0);
    if constexpr (!ALIGN_EPI) { if (wr == 0) PG8_BAR; }
    PG8_BAR;
    if constexpr (Epi::AFTER_DRAIN) { E.fused(acc, cur, wr, wc, fr, fq, lds, wid, lane); S.done(cur); }
#undef PG8_SA
#undef PG8_SB
#undef PG8_STAGE
#undef PG8_LDA
#undef PG8_LDB
#undef PG8_MMA
#undef PG8_CAT
#undef PG8_WAIT_V
#undef PG8_WAIT_L
#undef PG8_BAR
#undef PG8_SCHED
}
}

#ifndef PG8_SP2
#define PG8_SP2 true
#endif
#ifndef PG8_ALIGN
#define PG8_ALIGN true
#endif

constexpr int NWAVES = 8;
#ifndef MK_N_LAUNCHES
#define MK_N_LAUNCHES 1
#endif
constexpr int N_PHASES = 7;
#ifndef MK_DUP
#define PEER_PROBE 0
#define PEER_PROBE_U 0
#define PEER_PROBE_MASK 0xffff
#define MK_DUP 0
#endif
constexpr int DUP = MK_DUP;
constexpr int N_LAUNCHES = MK_N_LAUNCHES;

constexpr int BATCH = 4, SEQ = 8192, D = 1024, NMETA = 16;
constexpr int M = BATCH * SEQ;
constexpr int PROJW = 4104, NPROJ = 4096;
constexpr int NEXP = 16384, PEERN = 2048;
constexpr int LPOS = SEQ + NMETA;
constexpr int MPW = 2056;
constexpr float EPS = 1e-6f;
constexpr float KSCALE = 0.08838834764831845f;
constexpr float USCALE = 64.f, VSCALE = 5.656854f, XSCALE = 16.f;

constexpr size_t MiB = 1u << 20;
constexpr size_t WS_CTL = 0, CTL_ZERO_BYTES = 64 * 1024;
constexpr size_t WS_MP = 1 * MiB;
constexpr size_t WS_GS = 1 * MiB + 512 * 1024;
constexpr size_t WS_ROT = 2 * MiB;
constexpr size_t WS_GATES = 7 * MiB;
constexpr size_t WS_WIN = 8 * MiB;
constexpr size_t WS_SSQ = WS_WIN;
constexpr size_t WS_WOUT = 16 * MiB;
constexpr size_t WS_WPEER = 18 * MiB;
constexpr size_t WS_SLOC = 24 * MiB;
constexpr size_t WS_SMETA = 42 * MiB;
constexpr size_t WS_UD = 48 * MiB;
constexpr size_t WS_VU = 80 * MiB;
constexpr size_t WS_XN = 112 * MiB;
constexpr size_t WS_Y = 176 * MiB;
constexpr size_t WS_H1B = 400 * MiB;
constexpr size_t WS_SIG = 496 * MiB;
constexpr size_t WS_PROJ = 240 * MiB;
constexpr size_t WS_H1Q = 368 * MiB;
constexpr size_t WS_END = 497 * MiB;
constexpr size_t STATE_BYTES = 8 * 9 * 64 * 16;
constexpr int CW_BAR = 1024;

constexpr int RING_OFF = 0, RING_BYTES = 131072;
constexpr int LDSCTL_OFF = 148992, MISC_OFF = LDSCTL_OFF + 320;
constexpr int LDS_BYTES = 149504;
constexpr int L_PT = 98304, PT_STRIDE = 144, L_CIMG = 107520, L_NVEC = 140288, L_VEC0 = 140544, L_LNX = 142592, L_GS0 = 146688;

#define GAS __attribute__((address_space(1)))
#define LAS __attribute__((address_space(3)))
typedef unsigned short bf16;
typedef unsigned v4u __attribute__((ext_vector_type(4)));
typedef unsigned v2u __attribute__((ext_vector_type(2)));
typedef float f32x4 __attribute__((ext_vector_type(4)));
typedef float f32x2 __attribute__((ext_vector_type(2)));
typedef short bf16x8 __attribute__((ext_vector_type(8)));
typedef short s16x4 __attribute__((ext_vector_type(4)));
typedef short v4i16_t __attribute__((ext_vector_type(4)));
typedef __bf16 bf16x2_t __attribute__((ext_vector_type(2)));
typedef GAS unsigned gu32;
#define RLX_AGENT __ATOMIC_RELAXED, __HIP_MEMORY_SCOPE_AGENT
#define LDS_WAIT() asm volatile("s_waitcnt lgkmcnt(0)" ::: "memory")
#define VM_WAIT() asm volatile("s_waitcnt vmcnt(0)" ::: "memory")
__device__ __forceinline__ unsigned f2bf(float f) { unsigned u = __builtin_bit_cast(unsigned, f); return (u + 0x7fffu + ((u >> 16) & 1u)) >> 16; }
__device__ __forceinline__ unsigned pk4_fp8(float a, float b, float c, float d) { int w = 0; w = __builtin_amdgcn_cvt_pk_fp8_f32(__builtin_amdgcn_fmed3f(a, -448.f, 448.f), __builtin_amdgcn_fmed3f(b, -448.f, 448.f), w, false); w = __builtin_amdgcn_cvt_pk_fp8_f32(__builtin_amdgcn_fmed3f(c, -448.f, 448.f), __builtin_amdgcn_fmed3f(d, -448.f, 448.f), w, true); return (unsigned)w; }
__device__ __forceinline__ unsigned pk2(float lo, float hi) { const f32x2 v = {lo, hi}; return __builtin_bit_cast(unsigned, __builtin_convertvector(v, bf16x2_t)); }
__device__ __forceinline__ float bflo(unsigned w) { return __builtin_bit_cast(float, w << 16); }
__device__ __forceinline__ float bfhi(unsigned w) { return __builtin_bit_cast(float, w & 0xffff0000u); }
__device__ __forceinline__ float bf2f(short s) { return __builtin_bit_cast(float, ((unsigned)(unsigned short)s) << 16); }
__device__ __forceinline__ unsigned off_a(unsigned row, unsigned ch) { return 2048u * (row >> 3) + 512u * (ch >> 2) + 64u * (row & 7) + 16u * ((ch & 3) ^ ((row >> 2) & 3)); }
__device__ __forceinline__ unsigned lds_row_base(unsigned lane) { const unsigned l15 = lane & 15, g = lane >> 4; return 2048u * (l15 >> 3) + 64u * (l15 & 7) + 16u * (g ^ ((l15 >> 2) & 3)); }
__device__ __forceinline__ unsigned tr_base(unsigned lane, unsigned cpar, unsigned t) { const unsigned g = lane >> 4, q = (lane & 15) >> 2, p = lane & 3;
    return 2048u * g + 64u * q + 8u * (p & 1) + 256u * t + 32u * (cpar ^ (g & 1)) + 16u * ((p >> 1) ^ t); }
__device__ __forceinline__ s16x4 vtr(const LAS unsigned char* p) { return __builtin_bit_cast(s16x4, __builtin_amdgcn_ds_read_tr16_b64_v4i16((LAS v4i16_t*)p)); }
__device__ __forceinline__ bf16x8 cat8(s16x4 lo, s16x4 hi) { return (bf16x8){lo[0], lo[1], lo[2], lo[3], hi[0], hi[1], hi[2], hi[3]}; }
template <int CTRL> __device__ __forceinline__ float dpp_f(float v) { return __builtin_bit_cast(float, __builtin_amdgcn_mov_dpp(__builtin_bit_cast(int, v), CTRL, 0xf, 0xf, false)); }
__device__ __forceinline__ float row_sum16(float v) { v += dpp_f<0xB1>(v); v += dpp_f<0x4E>(v); v += dpp_f<0x141>(v); v += dpp_f<0x140>(v); return v; }
__device__ __forceinline__ float wave_sum(float v) {
    v = row_sum16(v);
    const float a = __builtin_bit_cast(float, __builtin_amdgcn_readlane(__builtin_bit_cast(int, v), 0)), b = __builtin_bit_cast(float, __builtin_amdgcn_readlane(__builtin_bit_cast(int, v), 16));
    const float c = __builtin_bit_cast(float, __builtin_amdgcn_readlane(__builtin_bit_cast(int, v), 32)), d = __builtin_bit_cast(float, __builtin_amdgcn_readlane(__builtin_bit_cast(int, v), 48));
    return (a + b) + (c + d);
}
__device__ __forceinline__ unsigned pack8_fp4(f32x4 a, f32x4 b) { unsigned w = 0u;
    w = __builtin_amdgcn_cvt_scalef32_pk_fp4_f32(w, a.x, a.y, 1.0f, 0); w = __builtin_amdgcn_cvt_scalef32_pk_fp4_f32(w, a.z, a.w, 1.0f, 1);
    w = __builtin_amdgcn_cvt_scalef32_pk_fp4_f32(w, b.x, b.y, 1.0f, 2); w = __builtin_amdgcn_cvt_scalef32_pk_fp4_f32(w, b.z, b.w, 1.0f, 3); return w; }
__device__ __forceinline__ void unpack8_fp4(unsigned w, f32x2 (&p)[4]) {
    p[0] = __builtin_amdgcn_cvt_scalef32_pk_f32_fp4(w, 1.0f, 0); p[1] = __builtin_amdgcn_cvt_scalef32_pk_f32_fp4(w, 1.0f, 1);
    p[2] = __builtin_amdgcn_cvt_scalef32_pk_f32_fp4(w, 1.0f, 2); p[3] = __builtin_amdgcn_cvt_scalef32_pk_f32_fp4(w, 1.0f, 3); }
__device__ __forceinline__ float dot2bf(unsigned w, unsigned x, float acc) { return __builtin_amdgcn_fdot2_f32_bf16(__builtin_bit_cast(bf16x2_t, w), __builtin_bit_cast(bf16x2_t, x), acc, false); }

#define XB_TMO      128
#define XB_XCNT(j)  (256  + 64 * (j))
#define XB_XSUB(j)  (1280 + 64 * (j))
#define XB_XGEN(j)  (2304 + 64 * (j))
#define XB_TOP      3328
#define XB_TOPGEN   3392
#define XCD_BAR_WORDS 3456
#define XB_SPIN_CAP (1u << 22)

__device__ __forceinline__ unsigned xb_ld(unsigned* p)              { return __hip_atomic_load(p, __ATOMIC_RELAXED, __HIP_MEMORY_SCOPE_AGENT); }
__device__ __forceinline__ unsigned xb_add(unsigned* p, unsigned v) { return __hip_atomic_fetch_add(p, v, __ATOMIC_RELAXED, __HIP_MEMORY_SCOPE_AGENT); }
__device__ __forceinline__ unsigned xb_xcc_id() { return (unsigned)__builtin_amdgcn_s_getreg((3 << 11) | 20) & 0xFu; }
#define XB_SPIN(cond, bar) do { unsigned _sp = 0; while (cond) { __builtin_amdgcn_s_sleep(1); \
    if ((++_sp & 255u) == 0u) { if (xb_ld(&(bar)[XB_TMO])) break; if (_sp > XB_SPIN_CAP) { atomicAdd(&(bar)[XB_TMO], 1u); break; } } } } while (0)

struct XcdBarrier {
    unsigned* bar; unsigned x;
    volatile LAS unsigned* st;
};

__device__ __forceinline__ XcdBarrier xcd_barrier_post(unsigned* bar, volatile LAS unsigned* st) {
    XcdBarrier b; b.bar = bar; b.x = xb_xcc_id(); b.st = st;
    if (threadIdx.x == 0) (void)xb_add(&bar[XB_XCNT(b.x)], 1u);
    return b;
}
__device__ __forceinline__ void xcd_barrier_complete(unsigned* bar, unsigned x, unsigned& nloc, unsigned& nx) {
    const unsigned G = gridDim.x * gridDim.y * gridDim.z;
    unsigned sum, cnt, mine, sp = 0u;
    for (;;) {
        sum = 0u; cnt = 0u; mine = 0u;
#pragma unroll
        for (unsigned j = 0; j < 16; ++j) { const unsigned c = xb_ld(&bar[XB_XCNT(j)]); sum += c; cnt += (c > 0u) ? 1u : 0u; mine = (j == x) ? c : mine; }
        if (sum == G) break;
        __builtin_amdgcn_s_sleep(1);
        if ((++sp & 255u) == 0u) { if (xb_ld(&bar[XB_TMO])) break; if (sp > XB_SPIN_CAP) { atomicAdd(&bar[XB_TMO], 1u); break; } }
    }
    nloc = mine > 0u ? mine : 1u; nx = cnt > 0u ? cnt : 1u;
}

__device__ __forceinline__ void xcd_barrier(const XcdBarrier& b) {
    asm volatile("s_waitcnt vmcnt(0)" ::: "memory");
    __syncthreads();
    if (threadIdx.x == 0) {
        unsigned* bar = b.bar;
        __builtin_amdgcn_s_waitcnt(0);
        unsigned nloc = b.st[0], nx = b.st[1];
        if (nloc == 0u) { xcd_barrier_complete(bar, b.x, nloc, nx); b.st[0] = nloc; b.st[1] = nx; }
        const unsigned old = xb_add(&bar[XB_XSUB(b.x)], 1u);
        const unsigned gen = old / nloc;
        if (old + 1u == (gen + 1u) * nloc) {
            __builtin_amdgcn_fence(__ATOMIC_RELEASE, "agent");
            asm volatile("s_waitcnt vmcnt(0)" ::: "memory");
            const unsigned og = xb_add(&bar[XB_TOP], 1u);
            const unsigned tg = og / nx;
            if (og + 1u == (tg + 1u) * nx) xb_add(&bar[XB_TOPGEN], 1u);
            else XB_SPIN(xb_ld(&bar[XB_TOPGEN]) == tg, bar);
            __builtin_amdgcn_fence(__ATOMIC_ACQUIRE, "agent");
            xb_add(&bar[XB_XGEN(b.x)], 1u);
            asm volatile("s_waitcnt vmcnt(0)" ::: "memory");
        } else {
            XB_SPIN(xb_ld(&bar[XB_XGEN(b.x)]) == gen, bar);
            __builtin_amdgcn_fence(__ATOMIC_ACQUIRE, "agent");
            asm volatile("s_waitcnt vmcnt(0)" ::: "memory");
        }
    }
    __syncthreads();
}

struct Args {
    const float* x; const float* meta; const float* norm1_w; const float* w_in; const float* gate_bias; const float* m_norm_w; const float* r_norm_w; const float* w_out;
    const float* norm2_w; const float* w_query; const float* sub_keys; const float* w_down; const float* w_up; const float* final_w;
    float* out; unsigned char* ws; float fzero; int imask; int izero;
};
struct Ctx { LAS unsigned char* lds; int tid, lane, wave, vcu, G; };
__device__ __forceinline__ Ctx fresh_ctx(const Ctx& C0) { Ctx C = C0; int t = C0.tid; asm volatile("" : "+v"(t)); C.tid = t; C.lane = t & 63; C.wave = __builtin_amdgcn_readfirstlane(t >> 6); return C; }

__device__ __forceinline__ int mp_src_col(int mc) { return mc < 512 ? 512 + mc : mc < 1024 ? 1024 + (mc - 512) : mc < 1536 ? 2560 + (mc - 1024) : mc < 2048 ? 3072 + (mc - 1536) : 4096 + (mc - 2048); }
__device__ __forceinline__ int win_dest_row(int o) {
    if (o < 2048 || o >= 3072) return o;
    const int base = o & ~127, d = o & 127;
    return base + (d < 64 ? 8 * (d >> 2) + (d & 3) : 8 * ((d - 64) >> 2) + 4 + (d & 3));
}
template <int MODE>
__device__ __forceinline__ void p0_transpose_item(const float* W, int K, int ldn, int N, bf16* WT, LAS float* scr, int item, int lane, const float* gain, const float* gain2) {
    const int nblk = N / 32, kb = item / nblk, nb = item % nblk, k0 = 64 * kb, n0 = 32 * nb;
    float cs = 1.f;
    if (MODE == 1) { const int o = n0 + (lane & 31); cs = ((o >= 512 && o < 1024) || (o >= 2560 && o < 3072)) ? KSCALE : 1.f; }
#pragma unroll 8
    for (int i = 0; i < 32; ++i) { const int kk = 2 * i + (lane >> 5); float v = W[(size_t)(k0 + kk) * ldn + n0 + (lane & 31)];
        if (MODE == 1) v *= gain[k0 + kk] * cs;
        if (MODE == 2) v *= (k0 + kk < 512) ? gain[k0 + kk] : gain2[k0 + kk - 512];
        scr[kk * 33 + (lane & 31)] = v; }
    LDS_WAIT(); asm volatile("" ::: "memory");
    const int c = lane & 7;
#pragma unroll
    for (int j = 0; j < 4; ++j) { const int n = (lane >> 3) + 8 * j; const LAS float* s = scr + (8 * c) * 33 + n;
        v4u o; o.x = pk2(s[0 * 33], s[1 * 33]); o.y = pk2(s[2 * 33], s[3 * 33]); o.z = pk2(s[4 * 33], s[5 * 33]); o.w = pk2(s[6 * 33], s[7 * 33]);
        const int drow = (MODE == 1) ? win_dest_row(n0 + n) : (n0 + n);
        *(GAS v4u*)(WT + (size_t)drow * K + k0 + 8 * c) = o; }
    LDS_WAIT(); asm volatile("" ::: "memory");
}

__device__ __forceinline__ void p0_prep(const Args& A, const Ctx& C) {
    unsigned char* ws = A.ws;
    const int tid = C.tid, lane = C.lane, wave = C.wave;
    const int gw = C.vcu * NWAVES + wave, NGW = C.G * NWAVES;
    const int gt = C.vcu * 512 + tid, NGT = C.G * 512;
    {
        constexpr int AMS = 1028;
        LAS float* AM = (LAS float*)(C.lds);
        LAS float* RED = (LAS float*)(C.lds + 16 * AMS * 4);
        constexpr int NIT = (MPW + 15) / 16;
        if (C.vcu < NIT) {
            for (int rr = 0; rr < 2; ++rr) { const int r = wave * 2 + rr; const float* mr = A.meta + (size_t)r * D;
                f32x4 v[4]; float s = 0.f;
#pragma unroll
                for (int j = 0; j < 4; ++j) { v[j] = *(const f32x4*)(mr + 4 * lane + 256 * j); s += (v[j].x * v[j].x + v[j].y * v[j].y) + (v[j].z * v[j].z + v[j].w * v[j].w); }
                const float rstd = 1.f / sqrtf(wave_sum(s) * (1.f / D) + EPS);
#pragma unroll
                for (int j = 0; j < 4; ++j) { const f32x4 g = *(const f32x4*)(A.norm1_w + 4 * lane + 256 * j); *(LAS f32x4*)(AM + r * AMS + 4 * lane + 256 * j) = v[j] * rstd * g; }
            }
        }
        __syncthreads();
        float* mp = (float*)(ws + WS_MP);
        for (int it = C.vcu; it < NIT; it += C.G) {
            const int mc0 = 16 * it, sc0 = mp_src_col(mc0), j16 = lane & 15, kq = lane >> 4;
            const bool colok = mc0 + j16 < MPW;
            const float* wp = A.w_in + (size_t)(128 * wave + kq) * PROJW + sc0 + j16;
            const LAS float* ap = AM + j16 * AMS + 128 * wave + kq;
            f32x4 acc = (f32x4){0.f, 0.f, 0.f, 0.f};
#pragma unroll 8
            for (int s4 = 0; s4 < 32; ++s4) {
                const float b = colok ? wp[(size_t)(4 * s4) * PROJW] : 0.f;
                acc = __builtin_amdgcn_mfma_f32_16x16x4f32(ap[4 * s4], b, acc, 0, 0, 0); }
#pragma unroll
            for (int r4 = 0; r4 < 4; ++r4) RED[wave * 256 + (4 * kq + r4) * 16 + j16] = acc[r4];
            __syncthreads();
            if (tid < 256) { float sum = 0.f;
#pragma unroll
                for (int w8 = 0; w8 < 8; ++w8) sum += RED[w8 * 256 + tid];
                const int r = tid >> 4, mc = mc0 + (tid & 15);
                if (mc < MPW) { if (mc >= 2048) sum += A.gate_bias[mc - 2048]; mp[r * MPW + mc] = sum; } }
            __syncthreads();
        }
        __syncthreads();
    }
    {
        LAS float* WG = (LAS float*)(C.lds);
        for (int i = tid; i < 2048; i += 512) { const int k = i >> 1, h4 = 4 * (i & 1);
            *(LAS f32x4*)(WG + k * 8 + h4) = *(const f32x4*)(A.w_in + (size_t)k * PROJW + 4096 + h4) * A.norm1_w[k]; }
        __syncthreads();
    }
    if (wave >= 6) {
    const int sw = C.vcu * 2 + (wave - 6), NSW = C.G * 2;
    {
        bf16* WP = (bf16*)(ws + WS_WPEER);
        const int l16 = lane & 15, kg = lane >> 4;
        auto split8 = [](const f32x4 a, const f32x4 b, bf16x8& hi, bf16x8& lo) {
            const float x[8] = {a.x, a.y, a.z, a.w, b.x, b.y, b.z, b.w};
#pragma unroll
            for (int e = 0; e < 8; e += 2) { const unsigned h = pk2(x[e], x[e + 1]); const unsigned l = pk2(x[e] - bflo(h), x[e + 1] - bfhi(h));
                hi[e] = (short)(h & 0xffffu); hi[e + 1] = (short)(h >> 16); lo[e] = (short)(l & 0xffffu); lo[e + 1] = (short)(l >> 16); } };
        for (int wi = sw; wi < 2048; wi += NSW) {
            const int it = wi >> 3, wt = wi & 7, hp = it >> 4, kb = it & 15, p = hp & 1;
            const float* krow = A.sub_keys + (size_t)p * 128 * 128 + (size_t)(16 * wt + l16) * 128 + 8 * kg;
            bf16x8 kh[4], kl[4];
#pragma unroll
            for (int s4 = 0; s4 < 4; ++s4) split8(*(const f32x4*)(krow + 32 * s4), *(const f32x4*)(krow + 32 * s4 + 4), kh[s4], kl[s4]);
#pragma unroll
            for (int kt = 0; kt < 4; ++kt) {
                const float* qrow = A.w_query + (size_t)(kb * 64 + kt * 16 + l16) * PEERN + hp * 128 + 8 * kg;
                f32x4 acc = (f32x4){0.f, 0.f, 0.f, 0.f};
#pragma unroll
                for (int s4 = 0; s4 < 4; ++s4) { bf16x8 ah, al; split8(*(const f32x4*)(qrow + 32 * s4), *(const f32x4*)(qrow + 32 * s4 + 4), ah, al);
                    acc = __builtin_amdgcn_mfma_f32_16x16x32_bf16(ah, kh[s4], acc, 0, 0, 0);
                    acc = __builtin_amdgcn_mfma_f32_16x16x32_bf16(ah, kl[s4], acc, 0, 0, 0);
                    acc = __builtin_amdgcn_mfma_f32_16x16x32_bf16(al, kh[s4], acc, 0, 0, 0); }
                const int k0 = kb * 64 + kt * 16 + 4 * kg; const f32x4 g2 = *(const f32x4*)(A.norm2_w + k0);
                *(GAS unsigned*)((unsigned char*)WP + (size_t)(hp * 128 + 16 * wt + l16) * D + k0) = pk4_fp8(acc[0] * g2.x * 256.f, acc[1] * g2.y * 256.f, acc[2] * g2.z * 256.f, acc[3] * g2.w * 256.f);
            }
        }
    }
    {
        LAS float* scr = (LAS float*)(C.lds + wave * 16384);
        constexpr int I_IN = (D / 64) * (NPROJ / 32), I_OUT = (D / 64) * (D / 32);
        for (int it = sw; it < I_IN + I_OUT; it += NSW) {
            if (it < I_IN) p0_transpose_item<1>(A.w_in, D, PROJW, NPROJ, (bf16*)(ws + WS_WIN), scr, it, lane, A.norm1_w, nullptr);
            else p0_transpose_item<2>(A.w_out, D, D, D, (bf16*)(ws + WS_WOUT), scr, it - I_IN, lane, A.m_norm_w, A.r_norm_w);
        }
    }
    {
        float* rot = (float*)(ws + WS_ROT);
        const int gt2 = sw * 64 + lane, NGT2 = NSW * 64; const int f = gt2 & 63; const double inv = exp(-(double)f * (9.210340371976184 / 64.0));
        for (int i = gt2; i < LPOS * 64; i += NGT2) { const int pos = i >> 6;
            const double ang = (double)pos * inv; const double kq = rint(ang * 0.15915494309189535);
            const float r = (float)fma(-kq, 6.283185307179586, ang);
            rot[(size_t)pos * 128 + f] = cosf(r); rot[(size_t)pos * 128 + 64 + f] = sinf(r); }
    }
    } else {
    const int gw6 = C.vcu * 6 + wave, NGW6 = C.G * 6;
    LAS float* WG = (LAS float*)(C.lds);
    {
        bf16* XN = (bf16*)(ws + WS_XN); float* GT = (float*)(ws + WS_GATES);
        float wg[4][4][8];
#pragma unroll
        for (int j = 0; j < 4; ++j)
#pragma unroll
            for (int e = 0; e < 4; ++e) { const int k = 4 * lane + 256 * j + e;
                const f32x4 w0 = *(const LAS f32x4*)(WG + k * 8), w1 = *(const LAS f32x4*)(WG + k * 8 + 4);
                wg[j][e][0] = w0.x; wg[j][e][1] = w0.y; wg[j][e][2] = w0.z; wg[j][e][3] = w0.w;
                wg[j][e][4] = w1.x; wg[j][e][5] = w1.y; wg[j][e][6] = w1.z; wg[j][e][7] = w1.w; }
        const float gb = A.gate_bias[lane & 7];
        f32x4 nv[4];
#pragma unroll
        for (int j = 0; j < 4; ++j) nv[j] = (gw6 < M) ? *(const f32x4*)(A.x + (size_t)gw6 * D + 4 * lane + 256 * j) : (f32x4){0.f, 0.f, 0.f, 0.f};
        for (int m = gw6; m < M; m += NGW6) {
            f32x4 v[4]; float s = 0.f;
#pragma unroll
            for (int j = 0; j < 4; ++j) v[j] = nv[j];
            if (m + NGW6 < M) {
#pragma unroll
                for (int j = 0; j < 4; ++j) nv[j] = *(const f32x4*)(A.x + (size_t)(m + NGW6) * D + 4 * lane + 256 * j); }
#pragma unroll
            for (int j = 0; j < 4; ++j) { s += (v[j].x * v[j].x + v[j].y * v[j].y) + (v[j].z * v[j].z + v[j].w * v[j].w); }
            const float wave_sum_v = wave_sum(s); const float rstd = 1.f / sqrtf(wave_sum_v * (1.f / D) + EPS);
            float gd[8];
#pragma unroll
            for (int q = 0; q < 8; ++q) gd[q] = 0.f;
#pragma unroll
            for (int j = 0; j < 4; ++j)
#pragma unroll
                for (int e = 0; e < 4; ++e)
#pragma unroll
                    for (int q = 0; q < 8; ++q) gd[q] += v[j][e] * wg[j][e][q];
            float mine = 0.f;
#pragma unroll
            for (int q = 0; q < 8; ++q) { const float t = wave_sum(gd[q]); mine = ((lane & 7) == q) ? t : mine; }
            if (lane < 8) GT[(size_t)m * 8 + lane] = mine * rstd + gb;
            if (lane == 8) ((float*)(ws + WS_SIG))[m] = sqrtf(wave_sum_v * (1.f / D) + EPS);
            GAS unsigned long long* o8 = (GAS unsigned long long*)(XN + (size_t)m * D) + lane;
#pragma unroll
            for (int j = 0; j < 4; ++j) o8[64 * j] = (unsigned long long)pk2(v[j].x * rstd, v[j].y * rstd) | ((unsigned long long)pk2(v[j].z * rstd, v[j].w * rstd) << 32);
        }
    }
    }

}

__device__ __forceinline__ float logsigf(float f) { return f >= 0.f ? -__logf(1.f + __expf(-f)) : f - __logf(1.f + __expf(f)); }
__device__ __forceinline__ float wave_scan64(float v) {
    v += __builtin_bit_cast(float, __builtin_amdgcn_update_dpp(0, __builtin_bit_cast(int, v), 0x111, 0xf, 0xf, true));
    v += __builtin_bit_cast(float, __builtin_amdgcn_update_dpp(0, __builtin_bit_cast(int, v), 0x112, 0xf, 0xf, true));
    v += __builtin_bit_cast(float, __builtin_amdgcn_update_dpp(0, __builtin_bit_cast(int, v), 0x114, 0xf, 0xf, true));
    v += __builtin_bit_cast(float, __builtin_amdgcn_update_dpp(0, __builtin_bit_cast(int, v), 0x118, 0xf, 0xf, true));
    v += __builtin_bit_cast(float, __builtin_amdgcn_update_dpp(0, __builtin_bit_cast(int, v), 0x142, 0xa, 0xf, false));
    v += __builtin_bit_cast(float, __builtin_amdgcn_update_dpp(0, __builtin_bit_cast(int, v), 0x143, 0xc, 0xf, false));
    return v;
}

template <bool FULL>
__device__ __forceinline__ void mixer_item(const Args& A, const Ctx& C, int item) {
    unsigned char* ws = A.ws;
    LAS unsigned char* lds = C.lds;
    const int tid = C.tid, lane = C.lane, w = C.wave, g4 = lane >> 4, l15 = lane & 15, tw = w >> 1, vh = w & 1;
    const int chain = item >> 3, grp = item & 7, b = chain >> 3, hh = chain & 7, hl = hh & 3;
    const bool isR = hh >= 4;
    const int qcol = (hh >> 2) * 2048 + 128 * hl, kcol = qcol + 512, vcol = qcol + 1024, ocol = qcol + 1536;
    const int row_base = b * SEQ + grp * 1024;
    const bf16* PROJ = (const bf16*)(ws + WS_PROJ);
    const float* GATES = (const float*)(ws + WS_GATES);
    const float lgam = log1pf(-exp2f(-5.f - (float)hl));
    f32x4* SL = (f32x4*)(ws + WS_SLOC); f32x4* SM = (f32x4*)(ws + WS_SMETA);
    float* GSUM = (float*)(ws + WS_GS);

    f32x4 accC[9];
#pragma unroll
    for (int nb = 0; nb < 9; ++nb) accC[nb] = (f32x4){0.f, 0.f, 0.f, 0.f};
    float gsum = 0.f;
    if (w >= 4) __builtin_amdgcn_s_setprio(1);
    f32x4 sjw[4], sjg[4];
    const unsigned rwb = lds_row_base(lane);
    const unsigned rb_q = rwb + 4096u * tw, rb_k = rwb + 4096u * vh, rb_c = rwb + 16384u * vh;
    const unsigned trb00 = tr_base(lane, 0, 0), trb01 = tr_base(lane, 0, 1), trb10 = tr_base(lane, 1, 0), trb11 = tr_base(lane, 1, 1);
    const unsigned trk0 = ((w & 1) ? trb10 : trb00) + 512u * (w >> 1), trk1 = ((w & 1) ? trb11 : trb01) + 512u * (w >> 1);
    const unsigned cimg_w = off_a(l15, 2 * w + (g4 >> 1)) + 8 * (g4 & 1);
    const unsigned tile_o = off_a(tid >> 4, tid & 15);
#define TRV(c_, ks_, t_) ((((c_) & 1) ? ((t_) ? trb11 : trb10) : ((t_) ? trb01 : trb00)) + 8192u * (ks_) + 512u * ((c_) >> 1))
#define L_QT(b_) ((b_) * 49152)
#define L_KT(b_) ((b_) * 49152 + 16384)
#define L_VT(b_) ((b_) * 49152 + 32768)
#define L_VEC(b_) (L_VEC0 + (b_) * 1024)
#define L_GS(b_) (L_GS0 + (b_) * 16)

    if (FULL) {
        if (grp == 0) {
#pragma unroll
            for (int nb = 0; nb < 9; ++nb) accC[nb] = SM[(size_t)chain * (STATE_BYTES / 16) + (w * 9 + nb) * 64 + lane];
        } else {
            float dec = 0.f;
            for (int gp = grp - 1; gp >= 0; --gp) {
                const float cf = __expf(dec);
#pragma unroll
                for (int nb = 0; nb < 9; ++nb) accC[nb] += SL[(size_t)(chain * 8 + gp) * (STATE_BYTES / 16) + (w * 9 + nb) * 64 + lane] * cf;
                dec += GSUM[chain * 8 + gp];
            }
        }
#pragma unroll
        for (int nb = 0; nb < 8; ++nb) { v2u o; o.x = pk2(accC[nb][0], accC[nb][1]); o.y = pk2(accC[nb][2], accC[nb][3]);
            *(LAS v2u*)(lds + L_CIMG + cimg_w + 4096 * nb) = o; }
        if (l15 == 0) { v2u o; o.x = pk2(accC[8][0], accC[8][1]); o.y = pk2(accC[8][2], accC[8][3]); *(LAS v2u*)(lds + L_NVEC + (16 * w + 4 * g4) * 2) = o; }
    }

    constexpr int PD = FULL ? 1 : 4;
    v4u pq[PD][2], pk[PD][2], pv[PD][2]; float gi[PD], gf[PD];
#define MX_PREFETCH(u_, c_) do { _Pragma("unroll") for (int i_ = 0; i_ < 2; ++i_) { const int p_ = tid + 512 * i_, r_ = p_ >> 4, ch_ = p_ & 15; const bf16* rp_ = PROJ + (size_t)(row_base + 64 * (c_) + r_) * NPROJ + 8 * ch_; \
            if (FULL) pq[u_][i_] = *(const v4u*)(rp_ + qcol); \
            pk[u_][i_] = *(const v4u*)(rp_ + kcol); pv[u_][i_] = *(const v4u*)(rp_ + vcol); } \
        if (w == 0 && !isR) { const float* gp_ = GATES + (size_t)(row_base + 64 * (c_) + lane) * 8; gi[u_] = gp_[hl]; gf[u_] = gp_[4 + hl]; } } while (0)
#define MX_STAGE_TILES(u_, b_) do { _Pragma("unroll") for (int i_ = 0; i_ < 2; ++i_) { const unsigned o_ = tile_o + 8192u * i_; \
            if (FULL) *(LAS v4u*)(lds + L_QT(b_) + o_) = pq[u_][i_]; \
            *(LAS v4u*)(lds + L_KT(b_) + o_) = pk[u_][i_]; *(LAS v4u*)(lds + L_VT(b_) + o_) = pv[u_][i_]; } } while (0)
#define MX_VECTORS(li__, lf__, b_) do { if (w == 0) { const float bs_ = wave_scan64(lf__); \
            const float gc_ = __builtin_bit_cast(float, __builtin_amdgcn_readlane(__builtin_bit_cast(int, bs_), 63)), aj_ = (li__) - bs_; LAS float* vb_ = (LAS float*)(lds + L_VEC(b_)); \
            vb_[lane] = bs_; vb_[64 + lane] = aj_; vb_[128 + lane] = __expf(gc_ + aj_); vb_[192 + lane] = __expf(bs_); \
            if (lane == 0) *(LAS float*)(lds + L_GS(b_)) = gc_; } } while (0)

    auto body = [&](auto UT, auto MT, const int c) {
        constexpr int U = decltype(UT)::value; constexpr bool META = decltype(MT)::value;
        constexpr int TB = FULL ? U : 0;
        if constexpr (FULL) {
            if (c + 2 < 16) MX_PREFETCH(0, c + 2);
            {
                const float* src = A.w_up + (size_t)(item * 8 + w + 2048 * (c >> 1)) * D + 512 * (c & 1) + 4 * lane;
                sjw[0] = *(const f32x4*)src; sjw[1] = *(const f32x4*)(src + 256); }
        } else if constexpr (!META) {
            MX_STAGE_TILES(U, 0); MX_VECTORS(isR ? 0.f : gi[U], isR ? lgam : logsigf(gf[U]), 0);
            __syncthreads();
            if (c + PD < 16) MX_PREFETCH(U, c + PD);
            {
                const int R = item * 8 + w + 2048 * (c >> 1); const float* src = A.w_down + (size_t)R * D + 512 * (c & 1) + 4 * lane;
#pragma unroll
                for (int j = 0; j < 2; ++j) { sjw[j] = *(const f32x4*)(src + 256 * j); sjg[j] = *(const f32x4*)(A.norm2_w + 512 * (c & 1) + 256 * j + 4 * lane); }
            }
        } else {
            const float* mp = (const float*)(ws + WS_MP); const float* rot = (const float*)(ws + WS_ROT);
#pragma unroll
            for (int i = 0; i < 2; ++i) { const int p = tid + 512 * i, r = p >> 4, ch = p & 15; const unsigned o = tile_o + 8192u * i;
                v4u kq = (v4u){0u, 0u, 0u, 0u}, vq = kq;
                if (r >= 48) { const int mr = r - 48; const float* mrow = mp + mr * MPW;
                    float kv[8], vv[8];
                    if (!isR) {
#pragma unroll
                        for (int e = 0; e < 8; ++e) { kv[e] = mrow[128 * hl + 8 * ch + e] * KSCALE; vv[e] = mrow[512 + 128 * hl + 8 * ch + e]; }
                    } else {
#pragma unroll
                        for (int e = 0; e < 4; ++e) { const float x1 = mrow[1024 + 128 * hl + 4 * ch + e], x2 = mrow[1024 + 128 * hl + 64 + 4 * ch + e];
                            const float cs = rot[mr * 128 + 4 * ch + e], sn = rot[mr * 128 + 64 + 4 * ch + e];
                            kv[e] = (x1 * cs - x2 * sn) * KSCALE; kv[4 + e] = (x1 * sn + x2 * cs) * KSCALE; }
#pragma unroll
                        for (int e = 0; e < 8; ++e) vv[e] = mrow[1536 + 128 * hl + 8 * ch + e];
                    }
                    kq.x = pk2(kv[0], kv[1]); kq.y = pk2(kv[2], kv[3]); kq.z = pk2(kv[4], kv[5]); kq.w = pk2(kv[6], kv[7]);
                    vq.x = pk2(vv[0], vv[1]); vq.y = pk2(vv[2], vv[3]); vq.z = pk2(vv[4], vv[5]); vq.w = pk2(vv[6], vv[7]);
                }
                *(LAS v4u*)(lds + L_KT(0) + o) = kq; *(LAS v4u*)(lds + L_VT(0) + o) = vq; }
            float li_ = 0.f, lf_ = 0.f;
            if (lane >= 48) { const float* mrow = mp + (lane - 48) * MPW + 2048; li_ = isR ? 0.f : mrow[hl]; lf_ = isR ? lgam : logsigf(mrow[4 + hl]); }
            MX_VECTORS(li_, lf_, 0);
            __syncthreads();
        }
        LAS float* bvec = (LAS float*)(lds + L_VEC(TB)); LAS float* avec = bvec + 64; LAS float* wvec = bvec + 128; LAS float* ebvec = bvec + 192;
        const float gch = *(LAS float*)(lds + L_GS(TB));
        if constexpr (!META) gsum += gch;
        v2u gqc[4];
#pragma unroll
        for (int vi = 0; vi < 4; ++vi) gqc[vi] = (v2u){0u, 0u};
        v4u gq16[2];
        if constexpr (FULL) { const bf16* gr_ = PROJ + (size_t)(row_base + 64 * c + 16 * tw + l15) * NPROJ + ocol + 64 * vh + 16 * (g4 & 1) + 8 * (g4 >> 1);
            gq16[0] = *(const v4u*)gr_; gq16[1] = *(const v4u*)(gr_ + 32); }

        f32x4 acc_o[5];
        if constexpr (FULL) {
            bf16x8 qf[4];
#pragma unroll
            for (int s = 0; s < 4; ++s) qf[s] = *(const LAS bf16x8*)(lds + L_QT(TB) + rb_q + 512 * s);
            const int t = 16 * tw + l15; const float bt = bvec[t];
#pragma unroll
            for (int jj = 0; jj < 2; ++jj) { const int jt = vh + 2 * jj;
                f32x4 sacc = (f32x4){0.f, 0.f, 0.f, 0.f};
#pragma unroll
                for (int s = 0; s < 4; ++s) { const bf16x8 kf = *(const LAS bf16x8*)(lds + L_KT(TB) + rb_k + 8192 * jj + 512 * s); sacc = __builtin_amdgcn_mfma_f32_16x16x32_bf16(kf, qf[s], sacc, 0, 0, 0); }
                const int j0 = 16 * jt + 4 * g4; const f32x4 a4 = *(const LAS f32x4*)(avec + j0);
                float pr[4];
#pragma unroll
                for (int r = 0; r < 4; ++r) pr[r] = (j0 + r <= t) ? sacc[r] * __expf(bt + a4[r]) : 0.f;
                v2u o; o.x = pk2(pr[0], pr[1]); o.y = pk2(pr[2], pr[3]);
                *(LAS v2u*)(lds + L_PT + t * PT_STRIDE + j0 * 2) = o; __builtin_amdgcn_sched_barrier(0); }
#pragma unroll
            for (int vi = 0; vi < 4; ++vi) { f32x4 a = (f32x4){0.f, 0.f, 0.f, 0.f};
#pragma unroll
                for (int s = 0; s < 4; ++s) { const bf16x8 cf = *(const LAS bf16x8*)(lds + L_CIMG + rb_c + 4096 * vi + 512 * s); a = __builtin_amdgcn_mfma_f32_16x16x32_bf16(cf, qf[s], a, 0, 0, 0); }
                acc_o[vi] = a; }
            { f32x4 a = (f32x4){0.f, 0.f, 0.f, 0.f};
#pragma unroll
                for (int s = 0; s < 4; ++s) { bf16x8 nf = *(const LAS bf16x8*)(lds + L_NVEC + (32 * s + 8 * g4) * 2); if (l15 != 0) nf = (bf16x8){0, 0, 0, 0, 0, 0, 0, 0};
                    a = __builtin_amdgcn_mfma_f32_16x16x32_bf16(nf, qf[s], a, 0, 0, 0); }
                acc_o[4] = a; }
            const float eb = ebvec[t];
#pragma unroll
            for (int vi = 0; vi < 5; ++vi) acc_o[vi] *= eb;
        }
        {
            const float eg = __expf(gch);
#pragma unroll
            for (int nb = 0; nb < 9; ++nb) accC[nb] *= eg;
#pragma unroll
            for (int ks = 0; ks < 2; ++ks) {
                const s16x4 klo = vtr(lds + L_KT(TB) + trk0 + 8192 * ks), khi = vtr(lds + L_KT(TB) + trk1 + 8192 * ks);
                const f32x4 w0 = *(const LAS f32x4*)(wvec + 32 * ks + 8 * g4), w1 = *(const LAS f32x4*)(wvec + 32 * ks + 8 * g4 + 4);
                v4u ap; ap.x = pk2(bf2f(klo[0]) * w0[0], bf2f(klo[1]) * w0[1]); ap.y = pk2(bf2f(klo[2]) * w0[2], bf2f(klo[3]) * w0[3]);
                ap.z = pk2(bf2f(khi[0]) * w1[0], bf2f(khi[1]) * w1[1]); ap.w = pk2(bf2f(khi[2]) * w1[2], bf2f(khi[3]) * w1[3]);
                const bf16x8 af = __builtin_bit_cast(bf16x8, ap);
#pragma unroll
                for (int nb = 0; nb < 8; ++nb) { const s16x4 vlo = vtr(lds + L_VT(TB) + TRV(nb, ks, 0)), vhi = vtr(lds + L_VT(TB) + TRV(nb, ks, 1));
                    accC[nb] = __builtin_amdgcn_mfma_f32_16x16x32_bf16(af, cat8(vlo, vhi), accC[nb], 0, 0, 0); }
                const short one = (l15 == 0) ? (short)0x3F80 : (short)0;
                accC[8] = __builtin_amdgcn_mfma_f32_16x16x32_bf16(af, (bf16x8){one, one, one, one, one, one, one, one}, accC[8], 0, 0, 0);
            }
        }
        if constexpr (!FULL) {
            if constexpr (META) {
#pragma unroll
                for (int nb = 0; nb < 9; ++nb) SM[(size_t)chain * (STATE_BYTES / 16) + (w * 9 + nb) * 64 + lane] = accC[nb];
            }
            if constexpr (!META) {
                const int R = item * 8 + w + 2048 * (c >> 1);
                unsigned char* dst = ws + WS_UD + (size_t)R * (D / 2);
#pragma unroll
                for (int j = 0; j < 2; ++j) { const int q = 128 * (c & 1) + 64 * j + lane;
                    const f32x4 vs = sjw[j] * sjg[j] * USCALE; unsigned wv = 0u;
                    wv = __builtin_amdgcn_cvt_scalef32_pk_fp4_f32(wv, vs.x, vs.y, 1.0f, 0); wv = __builtin_amdgcn_cvt_scalef32_pk_fp4_f32(wv, vs.z, vs.w, 1.0f, 1);
                    *(GAS unsigned short*)(dst + 2 * q) = (unsigned short)wv; }
            }
            __syncthreads();
        } else {
            __syncthreads();
            {
                const int nks = (tw >> 1) + 1;
#pragma unroll
                for (int ks = 0; ks < 2; ++ks) if (ks < nks) {
                    const bf16x8 pf = *(const LAS bf16x8*)(lds + L_PT + (16 * tw + l15) * PT_STRIDE + (32 * ks + 8 * g4) * 2);
#pragma unroll
                    for (int vi = 0; vi < 4; ++vi) {
                        const s16x4 vlo = vtr(lds + L_VT(TB) + 1024u * vh + TRV(vi, ks, 0)), vhi = vtr(lds + L_VT(TB) + 1024u * vh + TRV(vi, ks, 1));
                        acc_o[vi] = __builtin_amdgcn_mfma_f32_16x16x32_bf16(cat8(vlo, vhi), pf, acc_o[vi], 0, 0, 0); }
                    const short one = (l15 == 0) ? (short)0x3F80 : (short)0;
                    acc_o[4] = __builtin_amdgcn_mfma_f32_16x16x32_bf16((bf16x8){one, one, one, one, one, one, one, one}, pf, acc_o[4], 0, 0, 0);
                }
            }
#pragma unroll
            for (int nb = 0; nb < 8; ++nb) { v2u o; o.x = pk2(accC[nb][0], accC[nb][1]); o.y = pk2(accC[nb][2], accC[nb][3]);
                *(LAS v2u*)(lds + L_CIMG + cimg_w + 4096 * nb) = o; }
            if (l15 == 0) { v2u o; o.x = pk2(accC[8][0], accC[8][1]); o.y = pk2(accC[8][2], accC[8][3]); *(LAS v2u*)(lds + L_NVEC + (16 * w + 4 * g4) * 2) = o; }
            {
                const int t = 16 * tw + l15; const int row = row_base + 64 * c + t;
                float z[4][4];
                const float den = __shfl(acc_o[4][0], l15);
                const float inv = isR ? 1.f : __builtin_amdgcn_rcpf(fmaxf(fabsf(den), 1.f));
#pragma unroll
                for (int vp = 0; vp < 2; ++vp) { const auto sx = __builtin_amdgcn_permlane16_swap(gq16[vp].x, gq16[vp].z, false, false), sy = __builtin_amdgcn_permlane16_swap(gq16[vp].y, gq16[vp].w, false, false);
                    gqc[2 * vp] = (v2u){sx[0], sy[0]}; gqc[2 * vp + 1] = (v2u){sx[1], sy[1]}; }
                float s1 = 0.f, s2 = 0.f;
#pragma unroll
                for (int vi = 0; vi < 4; ++vi) { const v2u gv = gqc[vi]; const float g_[4] = {bflo(gv.x), bfhi(gv.x), bflo(gv.y), bfhi(gv.y)};
#pragma unroll
                    for (int r = 0; r < 4; ++r) { float zz = acc_o[vi][r] * inv; if (!isR) zz *= __builtin_amdgcn_rcpf(1.f + __expf(-g_[r])); z[vi][r] = zz; s1 += zz; s2 += zz * zz; } }
                LAS f32x2* lnx = (LAS f32x2*)(lds + L_LNX);
                lnx[t * 8 + vh * 4 + g4] = (f32x2){s1, s2};
                __syncthreads();
                if (c + 2 < 16) { MX_STAGE_TILES(0, TB); MX_VECTORS(isR ? 0.f : gi[0], isR ? lgam : logsigf(gf[0]), TB); }
                float t1 = 0.f, t2 = 0.f;
#pragma unroll
                for (int q = 0; q < 4; ++q) { const f32x4 pq_ = *(const LAS f32x4*)(lds + L_LNX + t * 64 + q * 16); t1 += pq_.x + pq_.z; t2 += pq_.y + pq_.w; }
                const float mean = t1 * (1.f / 128.f); const float var = fmaxf(t2 * (1.f / 128.f) - mean * mean, 0.f);
                const float rs = __builtin_amdgcn_rsqf(var + EPS);
                v2u yo[4];
#pragma unroll
                for (int vi = 0; vi < 4; ++vi) { float yv[4]; const v2u gv = gqc[vi]; const float g_[4] = {bflo(gv.x), bfhi(gv.x), bflo(gv.y), bfhi(gv.y)};
#pragma unroll
                    for (int r = 0; r < 4; ++r) { float y = (z[vi][r] - mean) * rs; if (isR) { const float gg = g_[r]; y *= gg * __builtin_amdgcn_rcpf(1.f + __expf(-gg)); } yv[r] = y; }
                    yo[vi].x = pk2(yv[0], yv[1]); yo[vi].y = pk2(yv[2], yv[3]); }
                bf16* yrow = (bf16*)(ws + WS_Y) + (size_t)row * D + hh * 128 + 64 * vh + 16 * (g4 & 1) + 8 * (g4 >> 1);
#pragma unroll
                for (int vp = 0; vp < 4; vp += 2) {
                    const auto sx = __builtin_amdgcn_permlane16_swap(yo[vp].x, yo[vp + 1].x, false, false), sy = __builtin_amdgcn_permlane16_swap(yo[vp].y, yo[vp + 1].y, false, false);
                    *(GAS v4u*)(yrow + 16 * vp) = (v4u){sx[0], sy[0], sx[1], sy[1]}; }
                {
                    unsigned char* dst = ws + WS_VU + (size_t)(item * 8 + w + 2048 * (c >> 1)) * (D / 2);
#pragma unroll
                    for (int j = 0; j < 2; ++j) { const int q = 128 * (c & 1) + 64 * j + lane; const f32x4 vs = sjw[j] * VSCALE; unsigned wv = 0u;
                        wv = __builtin_amdgcn_cvt_scalef32_pk_fp4_f32(wv, vs.x, vs.y, 1.0f, 0); wv = __builtin_amdgcn_cvt_scalef32_pk_fp4_f32(wv, vs.z, vs.w, 1.0f, 1);
                        *(GAS unsigned short*)(dst + 16 * (q & 31) + 4 * (q >> 6) + 2 * ((q >> 5) & 1)) = (unsigned short)wv; } }
            }
        }
    };
    if constexpr (FULL) {
        gi[0] = 0.f; gf[0] = 0.f;
        MX_PREFETCH(0, 0);
        MX_STAGE_TILES(0, 0); MX_VECTORS(isR ? 0.f : gi[0], isR ? lgam : logsigf(gf[0]), 0);
        MX_PREFETCH(0, 1);
        MX_STAGE_TILES(0, 1); MX_VECTORS(isR ? 0.f : gi[0], isR ? lgam : logsigf(gf[0]), 1);
        __syncthreads();
        for (int c0 = 0; c0 < 16; c0 += 2) {
            body(std::integral_constant<int, 0>{}, std::false_type{}, c0);
            body(std::integral_constant<int, 1>{}, std::false_type{}, c0 + 1);
        }
    } else {
        if (grp == 0) body(std::integral_constant<int, 0>{}, std::true_type{}, -1);
#pragma unroll
        for (int u = 0; u < PD; ++u) { gi[u] = 0.f; gf[u] = 0.f; MX_PREFETCH(u, u); }
        for (int c0 = 0; c0 < 16; c0 += PD) {
            body(std::integral_constant<int, 0>{}, std::false_type{}, c0);
            body(std::integral_constant<int, 1 % PD>{}, std::false_type{}, c0 + 1);
            body(std::integral_constant<int, 2 % PD>{}, std::false_type{}, c0 + 2);
            body(std::integral_constant<int, 3 % PD>{}, std::false_type{}, c0 + 3);
        }
    }
#undef MX_PREFETCH
#undef MX_STAGE_TILES
#undef MX_VECTORS
#undef L_QT
#undef L_KT
#undef L_VT
#undef L_VEC
#undef L_GS
    __builtin_amdgcn_s_setprio(0);
    if (!FULL) {
#pragma unroll
        for (int nb = 0; nb < 9; ++nb) SL[(size_t)item * (STATE_BYTES / 16) + (w * 9 + nb) * 64 + lane] = accC[nb];
        if (tid == 0) GSUM[item] = gsum;
    }
    __syncthreads();
}

template <int CTRL> __device__ __forceinline__ unsigned dpp_u(unsigned v) { return (unsigned)__builtin_amdgcn_mov_dpp((int)v, CTRL, 0xf, 0xf, false); }
template <int MASK> __device__ __forceinline__ unsigned row_xor(unsigned v) {
    if constexpr (MASK == 1) return dpp_u<0xB1>(v);
    else if constexpr (MASK == 2) return dpp_u<0x4E>(v);
    else if constexpr (MASK == 3) return dpp_u<0x1B>(v);
    else if constexpr (MASK == 4) return dpp_u<0x1B>(dpp_u<0x141>(v));
    else if constexpr (MASK == 7) return dpp_u<0x141>(v);
    else if constexpr (MASK == 8) return dpp_u<0x128>(v);
    else { static_assert(MASK == 15, "row_xor mask"); return dpp_u<0x140>(v); }
}
__device__ __forceinline__ unsigned umax_(unsigned a, unsigned b) { return a > b ? a : b; }
__device__ __forceinline__ unsigned umin_(unsigned a, unsigned b) { return a < b ? a : b; }
template <int R, int X, bool FLIP> __device__ __forceinline__ void rs_stage(unsigned (&v)[R], int l16) {
    if constexpr (X < R) {
#pragma unroll
        for (int r = 0; r < R; ++r) { const int r2 = r ^ X; if (r < r2) { const unsigned a = v[r], b = v[r2]; v[r] = umax_(a, b); v[r2] = umin_(a, b); } }
    } else {
        constexpr int M = FLIP ? ((X + 1) / R - 1) : (X / R);
        constexpr int HB = FLIP ? ((X + 1) / (2 * R)) : (X / R);
        const bool lower = (l16 & HB) == 0;
        if constexpr (FLIP) {
#pragma unroll
            for (int r = 0; r < R / 2; ++r) { const int r2 = R - 1 - r; const unsigned pa = row_xor<M>(v[r2]), pb = row_xor<M>(v[r]);
                v[r] = lower ? umax_(v[r], pa) : umin_(v[r], pa); v[r2] = lower ? umax_(v[r2], pb) : umin_(v[r2], pb); }
        } else {
#pragma unroll
            for (int r = 0; r < R; ++r) { const unsigned p = row_xor<M>(v[r]); v[r] = lower ? umax_(v[r], p) : umin_(v[r], p); }
        }
    }
}
template <int R, int K, int J> __device__ __forceinline__ void rs_half(unsigned (&v)[R], int l16) { if constexpr (J >= 1) { rs_stage<R, J, false>(v, l16); rs_half<R, K, J / 2>(v, l16); } }
template <int R, int K> __device__ __forceinline__ void rs_sort(unsigned (&v)[R], int l16) {
    if constexpr (K > 2) rs_sort<R, K / 2>(v, l16);
    rs_stage<R, K - 1, true>(v, l16); rs_half<R, K, K / 4>(v, l16);
}
template <int MASK> __device__ __forceinline__ void rs_merge_top16(unsigned (&v)[32]) {
    unsigned p[16];
#pragma unroll
    for (int i = 0; i < 16; ++i) p[i] = row_xor<MASK>(v[15 - i]);
#pragma unroll
    for (int i = 0; i < 16; ++i) v[i] = umax_(v[i], p[i]);
#pragma unroll
    for (int J = 8; J >= 1; J >>= 1)
#pragma unroll
        for (int r = 0; r < 16; ++r) { const int r2 = r ^ J; if (r < r2) { const unsigned a = v[r], b = v[r2]; v[r] = umax_(a, b); v[r2] = umin_(a, b); } }
}
__device__ __forceinline__ void rs_top16_q4(unsigned (&v)[32]) { rs_sort<32, 32>(v, 0); rs_merge_top16<1>(v); rs_merge_top16<2>(v); }
__device__ __forceinline__ unsigned f2key(float f) { const unsigned u = __builtin_bit_cast(unsigned, f); return (u & 0x80000000u) ? ~u : (u | 0x80000000u); }
__device__ __forceinline__ float key2f(unsigned k) { return __builtin_bit_cast(float, (k & 0x80000000u) ? (k & 0x7fffffffu) : ~k); }

constexpr int PEER_TPB = M / 256;
constexpr int L_SLOT = 0, SLOT_BYTES = 1024;
constexpr int L_FLAG = 131072, L_TAB = L_FLAG + 1024, L_PW = L_TAB + 256, PW_BYTES = 1024;
constexpr int PEER_NR = 4;
constexpr int L_XW = L_PW + PEER_NR * PW_BYTES, XW_BYTES = 1536;
static_assert(L_XW + 8 * XW_BYTES <= LDSCTL_OFF, "PEER LDS layout");
#ifndef MK_NPB
#define MK_NPB 256
#endif
__device__ __forceinline__ void peer_item(const Args& A, const Ctx& C, const int item) {
    unsigned char* ws = A.ws; LAS unsigned char* lds = C.lds;
    const int tid = C.tid, lane = C.lane, wave = C.wave;
    LAS int* TAB = (LAS int*)(lds + L_TAB);
    volatile LAS int* FLAG = (volatile LAS int*)(lds + L_FLAG);
    if (tid < 64) { int code = -1, cbase = 0;
        for (int i = 0; i < 16; ++i) { const int n = 16 / (i + 1); if (code < 0 && tid < cbase + n) code = i * 16 + (tid - cbase); cbase += n; }
        TAB[tid] = code; }
    if (tid < PEER_TPB) FLAG[tid] = 0;
    if (tid < 4) FLAG[PEER_TPB + tid] = 0;
    __syncthreads();
    const int tok_base = item * PEER_TPB;
    const _Float16* S = (const _Float16*)(ws + WS_PROJ); const float* SSQ = (const float*)(ws + WS_SSQ);
    if (wave < PEER_NR) {
        const int l4 = lane & 3, l8 = lane & 7;
        int tabc[8];
#pragma unroll
        for (int r = 0; r < 8; ++r) tabc[r] = TAB[l8 * 8 + r];
        LAS unsigned* SK = (LAS unsigned*)(lds + L_PW + wave * PW_BYTES);
        typedef _Float16 h8_t __attribute__((ext_vector_type(8)));
        h8_t nS[4]; float nss = 0.f;
#define PEER_PREFETCH_S(t_) do { const _Float16* sp_ = S + (size_t)(t_) * PEERN + 32 * lane; _Pragma("unroll") for (int i_ = 0; i_ < 4; ++i_) nS[i_] = *(const h8_t*)(sp_ + 8 * i_); \
            nss = SSQ[(size_t)(t_) * 64 + lane]; } while (0)
        PEER_PREFETCH_S(tok_base + wave);
#pragma unroll 1
        for (int ti = wave; ti < PEER_TPB; ti += PEER_NR) {
            const int tok = tok_base + ti;
            const float rstd2 = __builtin_amdgcn_rsqf(wave_sum(nss) * (1.f / D) + EPS);
            unsigned v[32];
#pragma unroll
            for (int i = 0; i < 4; ++i) { const h8_t s8 = nS[i];
#pragma unroll
                for (int k = 0; k < 8; ++k) { const float sf = (float)s8[k]; v[8 * i + k] = (f2key(sf) & ~127u) | (unsigned)(l4 * 32 + 8 * i + k); } }
            if (ti + PEER_NR < PEER_TPB) PEER_PREFETCH_S(tok + PEER_NR);
            LAS int* EI = (LAS int*)(lds + L_SLOT + ti * SLOT_BYTES); LAS float* GT = (LAS float*)(lds + L_SLOT + ti * SLOT_BYTES + 512);
            rs_top16_q4(v);
            if (l4 == 0) {
#pragma unroll
                for (int q = 0; q < 4; ++q) *(LAS v4u*)(SK + (lane >> 2) * 16 + 4 * q) = (v4u){v[4 * q], v[4 * q + 1], v[4 * q + 2], v[4 * q + 3]}; }
            __builtin_amdgcn_wave_barrier(); asm volatile("" ::: "memory");
            const int hd = lane >> 3;
            unsigned c[8];
#pragma unroll
            for (int r = 0; r < 8; ++r) { const int code = tabc[r]; unsigned key = 0u;
                if (code >= 0) { const float sum = key2f(SK[(2 * hd) * 16 + (code >> 4)] & ~127u) + key2f(SK[(2 * hd + 1) * 16 + (code & 15)] & ~127u); key = (f2key(sum) & ~255u) | (unsigned)code; }
                c[r] = key; }
            rs_sort<8, 64>(c, l8);
            const unsigned topk = (unsigned)__shfl((int)c[0], lane & ~7);
            const float mx = key2f(topk & ~255u) * rstd2;
            float ex[8]; float sm = 0.f;
#pragma unroll
            for (int r = 0; r < 8; ++r) { ex[r] = (l8 < 2) ? __expf(key2f(c[r] & ~255u) * rstd2 - mx) : 0.f; sm += ex[r]; }
            sm += dpp_f<0xB1>(sm);
            const float rsm = __builtin_amdgcn_rcpf(sm);
            {
                int ein[8]; unsigned long long blo[8], bhi[8]; int nlo = 0;
#pragma unroll
                for (int r = 0; r < 8; ++r) { const int code = (int)(c[r] & 255u);
                    const int n1 = (int)(SK[(2 * hd) * 16 + (code >> 4)] & 127u), n2 = (int)(SK[(2 * hd + 1) * 16 + (code & 15)] & 127u);
                    ein[r] = n1 * 128 + n2;
                    blo[r] = __ballot((l8 < 2) && (n1 < 64)); bhi[r] = __ballot((l8 < 2) && (n1 >= 64)); nlo += __popcll(blo[r]); }
                int plo = 0, phi = nlo;
#pragma unroll
                for (int r = 0; r < 8; ++r) {
                    const int mylo = plo + (int)__builtin_amdgcn_mbcnt_hi((unsigned)(blo[r] >> 32), __builtin_amdgcn_mbcnt_lo((unsigned)blo[r], 0u));
                    const int myhi = phi + (int)__builtin_amdgcn_mbcnt_hi((unsigned)(bhi[r] >> 32), __builtin_amdgcn_mbcnt_lo((unsigned)bhi[r], 0u));
                    if (l8 < 2) { const int pos = (ein[r] < 8192) ? mylo : myhi; EI[pos] = ein[r] * (D / 2); GT[pos] = ex[r] * rsm; }
                    plo += __popcll(blo[r]); phi += __popcll(bhi[r]); }
            }
            __builtin_amdgcn_wave_barrier(); asm volatile("" ::: "memory");
            asm volatile("s_waitcnt lgkmcnt(0)" ::: "memory");
            if (lane == 0) FLAG[ti] = 1;
        }
#undef PEER_PREFETCH_S
    }
    {
        __builtin_amdgcn_s_setprio(1);
        auto peer_claim = [&](int ctr) -> int { int c_ = 0; if (lane == 0) c_ = __hip_atomic_fetch_add((LAS int*)(lds + L_FLAG) + PEER_TPB + ctr, 1, __ATOMIC_RELAXED, __HIP_MEMORY_SCOPE_WORKGROUP); return __builtin_amdgcn_readfirstlane(c_); };
        auto flag_or = [&](int t_, int bit) { if (lane == 0) (void)__hip_atomic_fetch_or((LAS int*)(lds + L_FLAG) + t_, bit, __ATOMIC_RELAXED, __HIP_MEMORY_SCOPE_WORKGROUP); };
#define PEER_CLAIM() peer_claim(0)
        const unsigned char* UD = ws + WS_UD; const unsigned char* VU = ws + WS_VU;
        LAS unsigned char* X8 = lds + L_XW + wave * XW_BYTES; LAS float* TT = (LAS float*)(X8 + 1024);
        const bf16* H1B = (const bf16*)(ws + WS_H1B);
        v4u nX8; float nss = 0.f;
        typedef int i32x8 __attribute__((ext_vector_type(8))); typedef float f32x16 __attribute__((ext_vector_type(16)));
        unsigned amsk[4];
#pragma unroll
        for (int d = 0; d < 4; ++d) amsk[d] = ((((lane & 31) >> 4) == (lane >> 5)) && (((lane & 15) >> 2) == d)) ? (0xffu << (8 * (lane & 3))) : 0u;
        const int half = lane >> 5, l32 = lane & 31, cb = 2 * l32 + half;
#define PEER_PREFETCH_X(t_) do { nX8 = *(const v4u*)(ws + WS_H1Q + (size_t)(t_) * D + 16 * cb); nss = SSQ[(size_t)(t_) * 64 + lane]; } while (0)
        int ti = PEER_CLAIM(), ti_next = PEER_TPB;
        if (ti < PEER_TPB) PEER_PREFETCH_X(tok_base + ti);
#pragma unroll 1
        for (; ti < PEER_TPB; ti = ti_next) {
            const int tok = tok_base + ti;
            ti_next = PEER_CLAIM();
            const float rstd2 = __builtin_amdgcn_rsqf(wave_sum(nss) * (1.f / D) + EPS);
            {
                const v4u x8 = nX8;
                if (ti_next < PEER_TPB) PEER_PREFETCH_X(tok_base + ti_next);
                *(LAS v4u*)(X8 + 16 * cb) = x8;
            }
            while (FLAG[ti] == 0) __builtin_amdgcn_s_sleep(8);
            asm volatile("" ::: "memory");
            const LAS int* EI = (const LAS int*)(lds + L_SLOT + ti * SLOT_BYTES); const LAS float* GT = (const LAS float*)(lds + L_SLOT + ti * SLOT_BYTES + 512);
            float ttv[2];
            {
                const int m16 = lane & 15, kg = lane >> 4, xq = m16 >> 2, sl = m16 & 3;
                __builtin_amdgcn_wave_barrier(); asm volatile("" ::: "memory");
                i32x8 xb[2];
#pragma unroll
                for (int s2 = 0; s2 < 2; ++s2) { const LAS unsigned char* bp = X8 + 128 * (4 * s2 + (kg >> 1)) + 32 * sl + 16 * (kg & 1);
                    const v4u x0 = *(const LAS v4u*)bp, x1 = *(const LAS v4u*)(bp + 256);
                    xb[s2] = (i32x8){(int)x0.x, (int)x0.y, (int)x0.z, (int)x0.w, (int)x1.x, (int)x1.y, (int)x1.z, (int)x1.w}; }
                const unsigned char* rowp = UD + 64 * kg + 16 * sl;
                v4u ar[8][2];
#define PU_LOADG(k_, g_) do { const unsigned char* rp_ = rowp + (unsigned)EI[4 * (g_) + xq]; ar[k_][0] = *(const v4u*)rp_; ar[k_][1] = *(const v4u*)(rp_ + 256); } while (0)
#define PU_GROUP(k_, g_) do { const v4u c0_ = ar[k_][0], c1_ = ar[k_][1]; \
                    f32x4 au_ = (f32x4){0.f, 0.f, 0.f, 0.f}; \
                    au_ = __builtin_amdgcn_mfma_scale_f32_16x16x128_f8f6f4((i32x8){(int)c0_.x, (int)c0_.y, (int)c0_.z, (int)c0_.w, 0, 0, 0, 0}, xb[0], au_, 4  , 0  , 0, 0x7f7f7f7f, 0, 0x7f7f7f7f); \
                    au_ = __builtin_amdgcn_mfma_scale_f32_16x16x128_f8f6f4((i32x8){(int)c1_.x, (int)c1_.y, (int)c1_.z, (int)c1_.w, 0, 0, 0, 0}, xb[1], au_, 4  , 0  , 0, 0x7f7f7f7f, 0, 0x7f7f7f7f); \
                    float v_ = (sl == 0) ? au_[0] : (sl == 1) ? au_[1] : (sl == 2) ? au_[2] : au_[3];         \
                    v_ += dpp_f<0xB1>(v_); v_ += dpp_f<0x4E>(v_); \
                    if (m16 == 0) TT[4 * (g_) + kg] = v_; } while (0)
#pragma unroll
                for (int k = 0; k < 8; ++k) PU_LOADG(k, k);
#pragma unroll 1
                for (int g0 = 0; g0 < 24; g0 += 8) {
#pragma unroll
                    for (int k = 0; k < 8; ++k) { const v4u s0 = ar[k][0], s1 = ar[k][1]; PU_LOADG(k, g0 + 8 + k); const v4u n0 = ar[k][0], n1 = ar[k][1]; ar[k][0] = s0; ar[k][1] = s1; PU_GROUP(k, g0 + k); ar[k][0] = n0; ar[k][1] = n1; }
                }
#pragma unroll
                for (int k = 0; k < 8; ++k) PU_GROUP(k, 24 + k);
#undef PU_GROUP
#undef PU_LOADG
                __builtin_amdgcn_wave_barrier(); asm volatile("s_waitcnt lgkmcnt(0)" ::: "memory");
                ttv[0] = TT[lane]; ttv[1] = TT[lane + 64];
                __builtin_amdgcn_wave_barrier(); asm volatile("" ::: "memory");
            }
            constexpr float CFS = 64.f;
            unsigned cfp[2];
#pragma unroll
            for (int j = 0; j < 2; ++j) { const float tt = ttv[j] * (rstd2 * (1.f / (USCALE * XSCALE))); float c = GT[lane + 64 * j] * (0.5f * CFS) * tt * (1.f + erff(tt * 0.70710678118654752f));
                c = fminf(fmaxf(c, -448.f), 448.f);
                cfp[j] = ((unsigned)__builtin_amdgcn_cvt_pk_fp8_f32(c, c, 0, false) & 0xffffu) * 0x00010001u; }
            { LAS unsigned* CFS_ = (LAS unsigned*)(lds + L_SLOT + ti * SLOT_BYTES + 512); CFS_[lane] = cfp[0]; CFS_[lane + 64] = cfp[1]; }
            __builtin_amdgcn_wave_barrier(); asm volatile("s_waitcnt lgkmcnt(0)" ::: "memory");
            flag_or(ti, 6);
        }
#define PEER_PREFETCH_H(t_) do { const bf16* xp_ = H1B + (size_t)(t_) * D + 4 * lane; _Pragma("unroll") for (int b_ = 0; b_ < 4; ++b_) nH[b_] = *(const v2u*)(xp_ + 256 * b_); } while (0)
        v2u nH[4];
#pragma unroll 1
        for (int sub = 0; sub < 2; ++sub) {
        const int ebase = 64 * sub; int pend = -1;
        int tj = peer_claim(2 + sub), tj_next = PEER_TPB;
        v4u v8[16];
        if (tj < PEER_TPB) { if (sub) while ((FLAG[tj] & 8) == 0) __builtin_amdgcn_s_sleep(8); asm volatile("" ::: "memory"); PEER_PREFETCH_H(tok_base + tj);
            while ((FLAG[tj] & (2 << sub)) == 0) __builtin_amdgcn_s_sleep(8);
            asm volatile("" ::: "memory");
            const LAS int* EI0 = (const LAS int*)(lds + L_SLOT + tj * SLOT_BYTES);
#pragma unroll
            for (int q = 0; q < 16; ++q) v8[q] = *(const v4u*)(VU + (unsigned)(EI0[ebase + 2 * q + half] + 16 * l32)); }
#pragma unroll 1
        for (; tj < PEER_TPB; tj = tj_next) {
            const int tok = tok_base + tj;
            tj_next = peer_claim(2 + sub);
            const int tn = (tj_next < PEER_TPB) ? tj_next : tj;
            float* orow = A.out + (size_t)tok * D + 4 * lane;
            float xr[16];
#pragma unroll
            for (int b = 0; b < 4; ++b) { xr[4 * b] = bflo(nH[b].x); xr[4 * b + 1] = bfhi(nH[b].x); xr[4 * b + 2] = bflo(nH[b].y); xr[4 * b + 3] = bfhi(nH[b].y); }
            if (tj_next < PEER_TPB) { if (sub) while ((FLAG[tj_next] & 8) == 0) __builtin_amdgcn_s_sleep(8); asm volatile("" ::: "memory"); PEER_PREFETCH_H(tok_base + tj_next); }
            while ((FLAG[tj] & (2 << sub)) == 0) __builtin_amdgcn_s_sleep(8);
            asm volatile("" ::: "memory");
            const LAS int* EI = (const LAS int*)(lds + L_SLOT + tj * SLOT_BYTES); const LAS unsigned* CFL = (const LAS unsigned*)(lds + L_SLOT + tj * SLOT_BYTES + 512);
            constexpr float CFS = 64.f;
            f32x16 accv, accw;
#pragma unroll
            for (int i = 0; i < 16; ++i) { accv[i] = 0.f; accw[i] = 0.f; }
#define PV_ROW(q_, e0_) do { const unsigned c0_ = CFL[(e0_) + 2 * (q_)], c1_ = CFL[(e0_) + 2 * (q_) + 1]; \
                    const i32x8 a_ = {(int)(c0_ & amsk[0]), (int)(c0_ & amsk[1]), (int)(c0_ & amsk[2]), (int)(c0_ & amsk[3]), (int)(c1_ & amsk[0]), (int)(c1_ & amsk[1]), (int)(c1_ & amsk[2]), (int)(c1_ & amsk[3])}; \
                    const i32x8 b_ = {(int)v8[q_].x, (int)v8[q_].y, (int)v8[q_].z, (int)v8[q_].w, 0, 0, 0, 0}; \
                    if ((q_) & 1) accw = __builtin_amdgcn_mfma_scale_f32_32x32x64_f8f6f4(a_, b_, accw, 0  , 4  , 0, 0x7f7f7f7f, 0, 0x7f7f7f7f); \
                    else accv = __builtin_amdgcn_mfma_scale_f32_32x32x64_f8f6f4(a_, b_, accv, 0  , 4  , 0, 0x7f7f7f7f, 0, 0x7f7f7f7f); } while (0)
#pragma unroll 1
            for (int e0 = ebase; e0 < ebase + 32; e0 += 32) {
#pragma unroll
                for (int q = 0; q < 16; ++q) { PV_ROW(q, e0); v8[q] = *(const v4u*)(VU + (unsigned)(EI[e0 + 32 + 2 * q + half] + 16 * l32)); }
            }
            if (pend >= 0) { asm volatile("s_waitcnt vmcnt(16)" ::: "memory"); flag_or(pend, 8); pend = -1; }
            while ((FLAG[tn] & (2 << sub)) == 0) __builtin_amdgcn_s_sleep(8);
            asm volatile("" ::: "memory");
            { const LAS int* EIn = (const LAS int*)(lds + L_SLOT + tn * SLOT_BYTES);
#pragma unroll
              for (int q = 0; q < 16; ++q) { PV_ROW(q, ebase + 32); v8[q] = *(const v4u*)(VU + (unsigned)(EIn[ebase + 2 * q + half] + 16 * l32)); } }
#undef PV_ROW
            float acc[16];
#pragma unroll
            for (int i = 0; i < 16; ++i) acc[i] = (accv[i] + accw[i]) * (1.f / (CFS * VSCALE));
            float q2 = 0.f;
#pragma unroll
            for (int j = 0; j < 16; ++j) { xr[j] += acc[j]; q2 += xr[j] * xr[j]; }
            if (sub == 0) {
                bf16* hrow = (bf16*)(ws + WS_H1B) + (size_t)tok * D + 4 * lane;
#pragma unroll
                for (int b = 0; b < 4; ++b) *(GAS v2u*)(hrow + 256 * b) = (v2u){pk2(xr[4 * b], xr[4 * b + 1]), pk2(xr[4 * b + 2], xr[4 * b + 3])};
                pend = tj;
                continue;
            }
            q2 = wave_sum(q2);
            const float rf = __builtin_amdgcn_rsqf(q2 * (1.f / D) + EPS);
#pragma unroll
            for (int j = 0; j < 4; ++j) { const f32x4 fw = *(const f32x4*)(A.final_w + 256 * j + 4 * lane);
                __builtin_nontemporal_store((f32x4){xr[4 * j] * rf * fw.x, xr[4 * j + 1] * rf * fw.y, xr[4 * j + 2] * rf * fw.z, xr[4 * j + 3] * rf * fw.w}, (f32x4*)(orow + 256 * j)); }
        }
        if (pend >= 0) { asm volatile("s_waitcnt vmcnt(0)" ::: "memory"); flag_or(pend, 8); }
        }
#undef PEER_PREFETCH_H
#undef PEER_PREFETCH_X
#undef PEER_CLAIM
        __builtin_amdgcn_s_setprio(0);
    }
}

__device__ __forceinline__ void peer_tokens(const Args& A, const Ctx& C) {
    if (C.vcu >= MK_NPB) return;
    for (int item = C.vcu; item < M / PEER_TPB; item += MK_NPB) { peer_item(A, C, item); __syncthreads(); }
}

template <int LO, int HI> __global__ void __launch_bounds__(NWAVES * 64, 2) mk_fwd(Args args) {
    extern __shared__ __attribute__((aligned(16))) unsigned char lds_raw[];
    Ctx C;
    C.lds = (LAS unsigned char*)lds_raw;
    C.tid = threadIdx.x; C.lane = C.tid & 63; C.wave = __builtin_amdgcn_readfirstlane(C.tid >> 6);
    C.G = gridDim.x; { const int bx = blockIdx.x; C.vcu = (C.G % 8 == 0) ? (bx % 8) * (C.G / 8) + bx / 8 : bx; }
    volatile LAS unsigned* MISC = (volatile LAS unsigned*)(C.lds + MISC_OFF);
    gu32* ctl = (gu32*)(args.ws + WS_CTL);
    for (int u = C.tid; u < (LDS_BYTES - LDSCTL_OFF) / 4; u += NWAVES * 64) ((LAS unsigned*)(C.lds + LDSCTL_OFF))[u] = 0u;
    __syncthreads();
    XcdBarrier bar; bar.bar = (unsigned*)(ctl + CW_BAR); bar.x = 0; bar.st = nullptr;
    if (HI - LO > 1) bar = xcd_barrier_post((unsigned*)(ctl + CW_BAR), MISC + 8);
#define GRID_BAR() do { if (HI - LO > 1) xcd_barrier(bar); } while (0)
    constexpr int lo = LO, hi = HI;
#define IN(k) (lo <= (k) && (k) < hi)
#define BOTH(k) (IN(k) && IN((k) + 1))
    unsigned char* ws = args.ws;
    for (int rp = 0; rp < ((DUP & 1) ? 2 : 1); ++rp) if (IN(0)) { const Ctx Cp = fresh_ctx(C); p0_prep(args, Cp); if (BOTH(0)) GRID_BAR(); }
    for (int rp = 0; rp < ((DUP & 2) ? 2 : 1); ++rp) if (IN(1)) {
        pg8::Gemm g{(const pg8::bf16_t*)(ws + WS_XN), (const pg8::bf16_t*)(ws + WS_WIN), M, NPROJ, D}; pg8::StaticOrder S; S.init(M, NPROJ, C.G, (int)blockIdx.x);
        pg8::EpiProj E{(pg8::bf16_t*)(ws + WS_PROJ), (const float*)(ws + WS_ROT)};
        pg8::gemm_phase<pg8::EpiProj, pg8::StaticOrder, PG8_ALIGN, PG8_SP2>(C.lds + RING_OFF, g, S, E);
        if (BOTH(1)) GRID_BAR();
    }
    for (int rp = 0; rp < ((DUP & 4) ? 2 : 1); ++rp) if (IN(2)) { const Ctx Cp = fresh_ctx(C); for (int it = C.vcu; it < 256; it += C.G) mixer_item<false>(args, Cp, it); if (BOTH(2)) GRID_BAR(); }
    for (int rp = 0; rp < ((DUP & 8) ? 2 : 1); ++rp) if (IN(3)) { const Ctx Cp = fresh_ctx(C); for (int it = C.vcu; it < 256; it += C.G) mixer_item<true>(args, Cp, it); if (BOTH(3)) GRID_BAR(); }
    for (int rp = 0; rp < ((DUP & 16) ? 2 : 1); ++rp) if (IN(4)) {
        pg8::Gemm g{(const pg8::bf16_t*)(ws + WS_Y), (const pg8::bf16_t*)(ws + WS_WOUT), M, D, D}; pg8::StaticOrder S; S.init(M, D, C.G, (int)blockIdx.x);
        pg8::EpiOut E{(const pg8::bf16_t*)(ws + WS_XN), (const float*)(ws + WS_SIG), (pg8::bf16_t*)(ws + WS_H1B), (float*)(ws + WS_SSQ), ws + WS_H1Q};
        pg8::gemm_phase<pg8::EpiOut, pg8::StaticOrder, PG8_ALIGN, PG8_SP2>(C.lds + RING_OFF, g, S, E);
        if (BOTH(4)) GRID_BAR();
    }
    for (int rp = 0; rp < ((DUP & 32) ? 2 : 1); ++rp) if (IN(5)) {
        pg8::Gemm g{(const pg8::bf16_t*)(ws + WS_H1Q), (const pg8::bf16_t*)(ws + WS_WPEER), M, PEERN, D / 2}; pg8::StaticOrder S; S.init(M, PEERN, C.G, (int)blockIdx.x);
        pg8::EpiF16 E{(unsigned short*)(ws + WS_PROJ), PEERN};
        pg8::gemm_phase<pg8::EpiF16, pg8::StaticOrder, PG8_ALIGN, false, true>(C.lds + RING_OFF, g, S, E);
        if (BOTH(5)) GRID_BAR();
    }
    if (IN(6)) { const Ctx Cp = fresh_ctx(C); peer_tokens(args, Cp); }
#undef IN
#undef BOTH
}

typedef void (*kern_t)(Args);
static kern_t kern_for(int li) {
    if constexpr (N_LAUNCHES == 1) return mk_fwd<0, N_PHASES>;
    else switch (li) { case 0: return mk_fwd<0, 1>; case 1: return mk_fwd<1, 2>; case 2: return mk_fwd<2, 3>; case 3: return mk_fwd<3, 4>; case 4: return mk_fwd<4, 5>; case 5: return mk_fwd<5, 6>; default: return mk_fwd<6, 7>; }
}
extern "C" void kernel_launch(void* const* d_in, const int* in_sizes, int n_in, void* d_out, int out_size, void* d_ws, size_t ws_size, hipStream_t stream) {
    static int grid = 0;
    if (grid == 0) {
        if (n_in != 14 || in_sizes[0] != M * D || out_size != M * D || ws_size < WS_END) { fprintf(stderr, "kernel_launch: unexpected shapes (n_in %d, in0 %d, out %d, ws %zu < %zu); nothing launched\n", n_in, n_in > 0 ? in_sizes[0] : -1, out_size, ws_size, (size_t)WS_END); grid = -1; return; }
        int dev = 0, cus = 0;
        if (hipGetDevice(&dev) != hipSuccess || hipDeviceGetAttribute(&cus, hipDeviceAttributeMultiprocessorCount, dev) != hipSuccess) { grid = -1; return; }
        for (int li = 0; li < N_LAUNCHES; ++li) {
            int per_cu = 0;
            if (hipFuncSetAttribute((const void*)kern_for(li), hipFuncAttributeMaxDynamicSharedMemorySize, LDS_BYTES) != hipSuccess) { fprintf(stderr, "kernel_launch: hipFuncSetAttribute failed\n"); grid = -1; return; }
            if (hipOccupancyMaxActiveBlocksPerMultiprocessor(&per_cu, (const void*)kern_for(li), NWAVES * 64, LDS_BYTES) != hipSuccess || per_cu < 1) { fprintf(stderr, "kernel_launch: occupancy query says %d blocks per CU for launch %d\n", per_cu, li); (void)hipGetLastError(); grid = -1; return; }
        }
        (void)hipGetLastError();
        grid = cus;
    }
    if (grid < 0) return;
    if (hipMemsetAsync((char*)d_ws + WS_CTL, 0, CTL_ZERO_BYTES, stream) != hipSuccess) { fprintf(stderr, "kernel_launch: memset failed\n"); return; }
    Args a{};
    a.x = (const float*)d_in[0]; a.meta = (const float*)d_in[1]; a.norm1_w = (const float*)d_in[2]; a.w_in = (const float*)d_in[3]; a.gate_bias = (const float*)d_in[4];
    a.m_norm_w = (const float*)d_in[5]; a.r_norm_w = (const float*)d_in[6]; a.w_out = (const float*)d_in[7]; a.norm2_w = (const float*)d_in[8]; a.w_query = (const float*)d_in[9];
    a.sub_keys = (const float*)d_in[10]; a.w_down = (const float*)d_in[11]; a.w_up = (const float*)d_in[12]; a.final_w = (const float*)d_in[13];
    a.out = (float*)d_out; a.ws = (unsigned char*)d_ws; a.fzero = 0.f; a.imask = PEER_PROBE_MASK; a.izero = 0;
    for (int li = 0; li < N_LAUNCHES; ++li) {
        hipLaunchKernelGGL(kern_for(li), dim3(grid), dim3(NWAVES * 64), LDS_BYTES, stream, a);
        const hipError_t le = hipPeekAtLastError();
        if (le != hipSuccess) { fprintf(stderr, "kernel_launch: launch %d failed: %s\n", li, hipGetErrorName(le)); break; }
    }
}
```
